# Optimizing an MI355X kernel written in HIP

```python
import math
import jax, jax.numpy as jnp
from jax import lax
import numpy as np

D_MODEL = 1024
BATCH = 4
SEQ = 4096
DEPTH = 2

GRID_W = 64
CTX_LEN = 256
Q_BLOCK = 128
ROPE_BASE = 10000.0
NORM_EPS = 1e-6
SUBLN_EPS = 1e-5

A_HEADS = 4
A_DIM = 64
A_WIDTH = A_HEADS * 2 * A_DIM
A_COLS = 3 * A_WIDTH
B_HEADS = 4
B_NOPE = 64
B_ROPE = 32
B_VDIM = 64
B_Q_RANK = 192
B_KV_RANK = 128
B_WIDTH = B_HEADS * B_VDIM
B_COLS = B_Q_RANK + B_KV_RANK + B_ROPE
C_HEADS = 4
C_DIM = 64
C_WIDTH = C_HEADS * C_DIM
C_DECAY_LORA = 64
C_ICLR_LORA = 64
C_GATE_LORA = 128
C_GN_EPS = 64e-5
C_COLS = 3 * C_WIDTH + 2 * C_DECAY_LORA + 2 * C_ICLR_LORA + C_GATE_LORA

D_MIX = A_WIDTH + B_WIDTH + C_WIDTH
N_IN = A_COLS + B_COLS + C_COLS
IN_SPLITS = [A_COLS, A_COLS + B_COLS]
C_SPLITS = [int(s) for s in np.cumsum([C_WIDTH, C_WIDTH, C_WIDTH, C_DECAY_LORA, C_DECAY_LORA, C_ICLR_LORA, C_ICLR_LORA])]

D_FF = 256 * ((8 * D_MODEL // 3 + 255) // 256)

kernel_name = "hybrid_dit_diffattn_mla_rwkv7_block"

F32 = jnp.float32


def rmsnorm(x, gain, eps=NORM_EPS):
    x32 = x.astype(F32)
    y = x32 * lax.rsqrt(jnp.mean(x32 * x32, axis=-1, keepdims=True) + eps)
    return (y * gain.astype(F32)).astype(x.dtype)


def shift_prev(x):
    return jnp.pad(x, ((0, 0), (1, 0), (0, 0)))[:, :-1]


def shift_next(x):
    return jnp.pad(x, ((0, 0), (0, 1), (0, 0)))[:, 1:]


def dwconv3(x, w, b):
    return shift_prev(x) * w[0] + x * w[1] + shift_next(x) * w[2] + b


def rope_angles(rows, cols, dim):
    nf = dim // 4
    inv = ROPE_BASE ** (-jnp.arange(nf, dtype=F32) / nf)
    return jnp.concatenate([rows.astype(F32)[:, None] * inv, cols.astype(F32)[:, None] * inv], axis=-1)


def axial_rope(x, ang):
    T, d = x.shape[1], x.shape[-1]
    nf = d // 4
    xs = x.astype(F32).reshape(*x.shape[:-1], 2, 2, nf)
    x1, x2 = xs[..., 0, :], xs[..., 1, :]
    a = ang.reshape(T, 1, 2, nf)
    cos, sin = jnp.cos(a), jnp.sin(a)
    out = jnp.stack([x1 * cos - x2 * sin, x2 * cos + x1 * sin], axis=-2)
    return out.reshape(x.shape).astype(x.dtype)


def over_query_blocks(fn, *qs):
    Bt, T = qs[0].shape[:2]
    nb = T // Q_BLOCK
    split = lambda a: jnp.moveaxis(a.reshape(Bt, nb, Q_BLOCK, *a.shape[2:]), 1, 0)
    out = lax.map(lambda qb: fn(*qb), tuple(split(q) for q in qs))
    return jnp.moveaxis(out, 0, 1).reshape(Bt, T, *out.shape[3:])


def softmax32(s):
    return jax.nn.softmax(s.astype(F32), axis=-1)


def diff_qkv(pa, ang):
    Bt, T = pa.shape[:2]
    q, k, v = jnp.split(pa, 3, axis=-1)
    q = q.reshape(Bt, T, 2 * A_HEADS, A_DIM)
    k = k.reshape(Bt, T, 2 * A_HEADS, A_DIM)
    if ang is not None:
        q = axial_rope(q, ang)
        k = axial_rope(k, ang)
    q = q.reshape(Bt, T, A_HEADS, 2, A_DIM)
    k = k.reshape(Bt, T, A_HEADS, 2, A_DIM)
    v = v.reshape(Bt, T, A_HEADS, 2 * A_DIM)
    return q[..., 0, :], q[..., 1, :], k[..., 0, :], k[..., 1, :], v


def diff_attn(q1, q2, k1, k2, v, lam):
    scale = A_DIM ** -0.5
    p1 = softmax32(jnp.einsum('bqhd,bkhd->bhqk', q1, k1) * scale)
    p2 = softmax32(jnp.einsum('bqhd,bkhd->bhqk', q2, k2) * scale)
    a = (p1 - lam * p2).astype(v.dtype)
    return jnp.einsum('bhqk,bkhe->bqhe', a, v)


def mla_qkv(pb, P, ang):
    Bt, T = pb.shape[:2]
    cq, ckv, kr = jnp.split(pb, [B_Q_RANK, B_Q_RANK + B_KV_RANK], axis=-1)
    q = (rmsnorm(cq, P['b_q_norm_g']) @ P['b_w_q_up']).reshape(Bt, T, B_HEADS, B_NOPE + B_ROPE)
    kv = (rmsnorm(ckv, P['b_kv_norm_g']) @ P['b_w_kv_up']).reshape(Bt, T, B_HEADS, B_NOPE + B_VDIM)
    q_nope, q_rope = q[..., :B_NOPE], q[..., B_NOPE:]
    k_nope, v = kv[..., :B_NOPE], kv[..., B_NOPE:]
    kr = kr[:, :, None, :]
    if ang is not None:
        q_rope = axial_rope(q_rope, ang)
        kr = axial_rope(kr, ang)
    k = jnp.concatenate([k_nope, jnp.broadcast_to(kr, (Bt, T, B_HEADS, B_ROPE))], axis=-1)
    q = jnp.concatenate([q_nope, q_rope], axis=-1)
    return q, k, v


def softmax_attn(q, k, v):
    scale = (B_NOPE + B_ROPE) ** -0.5
    p = softmax32(jnp.einsum('bqhd,bkhd->bhqk', q, k) * scale).astype(v.dtype)
    return jnp.einsum('bhqk,bkhe->bqhe', p, v)


def rwkv7_scan(S0, r, w, k, v, a, b, reverse):
    def step(S, inp):
        r_t, w_t, k_t, v_t, a_t, b_t = inp
        sa = jnp.einsum('bhvk,bhk->bhv', S, a_t)
        S = S * w_t[:, :, None, :] + sa[..., None] * b_t[:, :, None, :] + v_t[..., None] * k_t[:, :, None, :]
        return S, jnp.einsum('bhvk,bhk->bhv', S, r_t)
    xs = tuple(jnp.moveaxis(t.astype(F32), 1, 0) for t in (r, w, k, v, a, b))
    S, ys = lax.scan(step, S0, xs, reverse=reverse)
    return S, jnp.moveaxis(ys, 0, 1)


def rwkv7_mix(pc, S0_f, S0_b, P, want_out):
    Bt, T, _ = pc.shape
    pc = pc + P['c_mu_prev'] * (shift_prev(pc) - pc) + P['c_mu_next'] * (shift_next(pc) - pc)
    r, k, v, wl_f, wl_b, al_f, al_b, gl = jnp.split(pc, C_SPLITS, axis=-1)
    heads = lambda t: t.reshape(Bt, T, C_HEADS, C_DIM)
    kk = heads(k * P['c_k_k']).astype(F32)
    kk = kk / jnp.maximum(jnp.linalg.norm(kk, axis=-1, keepdims=True), 1e-12)
    r_h, v_h, k_h = heads(r), heads(v), heads(k)
    k_a = P['c_k_a'].reshape(C_HEADS, C_DIM)
    states, ys, bonuses = [], [], []
    for d, (wl, al, S0, rev) in enumerate(((wl_f, al_f, S0_f, False), (wl_b, al_b, S0_b, True))):
        w = -jax.nn.softplus(-(P['c_w0'][d] + jnp.tanh(wl) @ P['c_w2'][d])) - 0.5
        decay = jnp.exp(-jnp.exp(w.astype(F32)))
        a = heads(jax.nn.sigmoid(P['c_a0'][d] + al @ P['c_a2'][d]))
        kd = k_h * (1 + (a - 1) * k_a)
        S, y = rwkv7_scan(S0, r_h, heads(decay), kd, v_h, -kk, kk * a, rev)
        states.append(S)
        ys.append(y)
        bonuses.append(jnp.sum(r_h * kd * P['c_r_k'], axis=-1, keepdims=True) * v_h)
    if not want_out:
        return None, states[0], states[1]
    y = ys[0] + ys[1]
    mu = jnp.mean(y, axis=-1, keepdims=True)
    var = jnp.mean(jnp.square(y - mu), axis=-1, keepdims=True)
    yn = ((y - mu) * lax.rsqrt(var + C_GN_EPS)).reshape(Bt, T, C_WIDTH) * P['c_gn_g'] + P['c_gn_b']
    yn = yn + (bonuses[0] + bonuses[1]).reshape(Bt, T, C_WIDTH)
    out = yn * (jax.nn.sigmoid(gl) @ P['c_g2'])
    return out.astype(pc.dtype), states[0], states[1]


def merge_groups(oa, ob, oc, P, lam_init):
    Bt, T = oa.shape[:2]
    oa = (rmsnorm(oa, P['a_subln_g'], SUBLN_EPS) * (1 - lam_init)).reshape(Bt, T, A_WIDTH)
    ob = ob.reshape(Bt, T, B_WIDTH)
    return jnp.concatenate([oa, ob, oc], axis=-1) @ P['w_out']


def token_mix(h, hc, P, lam_init, ang_a, ang_b, ctx_out):
    p = h @ P['w_in']
    pc = hc @ P['w_in']
    pa, pb, pr = jnp.split(p, IN_SPLITS, axis=-1)
    pca, pcb, pcr = jnp.split(pc, IN_SPLITS, axis=-1)
    q1, q2, k1, k2, v = diff_qkv(pa, ang_a)
    cq1, cq2, ck1, ck2, cv = diff_qkv(pca, None)
    lam = (jnp.exp(jnp.sum(P['lam_q1'] * P['lam_k1']).astype(F32))
           - jnp.exp(jnp.sum(P['lam_q2'] * P['lam_k2']).astype(F32)) + lam_init)
    K1 = jnp.concatenate([ck1, k1], axis=1)
    K2 = jnp.concatenate([ck2, k2], axis=1)
    V = jnp.concatenate([cv, v], axis=1)
    oa = over_query_blocks(lambda a_, b_: diff_attn(a_, b_, K1, K2, V, lam), q1, q2)
    qb, kb, vb = mla_qkv(pb, P, ang_b)
    cqb, ckb, cvb = mla_qkv(pcb, P, None)
    Kb = jnp.concatenate([ckb, kb], axis=1)
    Vb = jnp.concatenate([cvb, vb], axis=1)
    ob = over_query_blocks(lambda q_: softmax_attn(q_, Kb, Vb), qb)
    zero = jnp.zeros((h.shape[0], C_HEADS, C_DIM, C_DIM), F32)
    ocr, S_f, S_b = rwkv7_mix(pcr, zero, zero, P, ctx_out)
    orr, _, _ = rwkv7_mix(pr, S_f, S_b, P, True)
    o = merge_groups(oa, ob, orr, P, lam_init)
    if not ctx_out:
        return o, None
    oc = merge_groups(diff_attn(cq1, cq2, ck1, ck2, cv, lam), softmax_attn(cqb, ckb, cvb), ocr, P, lam_init)
    return o, oc


def conv_ffn(h, P):
    u = dwconv3(h @ P['ffn_w_up'], P['ffn_conv_w'], P['ffn_conv_b'])
    g, v = jnp.split(u, 2, axis=-1)
    return (jax.nn.silu(g) * v) @ P['ffn_w_down']


def trunk_layer(x, xc, c_act, cc_act, P, lam_init, ang_a, ang_b, ctx_out):
    mod = (c_act @ P['ada_w'] + P['ada_b'])[:, None, :]
    modc = (cc_act @ P['ada_w'] + P['ada_b'])[None, None, :]
    sh1, sc1, gt1, sh2, sc2, gt2 = jnp.split(mod, 6, axis=-1)
    csh1, csc1, cgt1, csh2, csc2, cgt2 = jnp.split(modc, 6, axis=-1)
    h = rmsnorm(x, P['mix_pre_g']) * (1 + sc1) + sh1
    hc = rmsnorm(xc, P['mix_pre_g']) * (1 + csc1) + csh1
    o, oc = token_mix(h, hc, P, lam_init, ang_a, ang_b, ctx_out)
    x = x + gt1 * rmsnorm(o, P['mix_post_g'])
    h = rmsnorm(x, P['ffn_pre_g']) * (1 + sc2) + sh2
    x = x + gt2 * rmsnorm(conv_ffn(h, P), P['ffn_post_g'])
    if ctx_out:
        xc = xc + cgt1 * rmsnorm(oc, P['mix_post_g'])
        hc = rmsnorm(xc, P['ffn_pre_g']) * (1 + csc2) + csh2
        xc = xc + cgt2 * rmsnorm(conv_ffn(hc, P), P['ffn_post_g'])
    return x, xc


def setup_inputs(seed: int = 0) -> dict:
    key = jax.random.key(seed)
    ks = iter(jax.random.split(key, 48))
    nrm = lambda shape, s: jax.random.normal(next(ks), shape, F32) * s
    uni = lambda shape, lo, hi: jax.random.uniform(next(ks), shape, F32, lo, hi)
    L = DEPTH
    return {
        "x": nrm((BATCH, SEQ, D_MODEL), 1.0),
        "c": nrm((BATCH, D_MODEL), 1.0),
        "ctx": nrm((BATCH, CTX_LEN, D_MODEL), 1.0),
        "c_ctx": nrm((D_MODEL,), 1.0),
        "ada_w": nrm((L, D_MODEL, 6 * D_MODEL), 0.5 * D_MODEL ** -0.5),
        "ada_b": nrm((L, 6 * D_MODEL), 0.01),
        "mix_pre_g": 1.0 + nrm((L, D_MODEL), 0.02),
        "mix_post_g": 1.0 + nrm((L, D_MODEL), 0.02),
        "ffn_pre_g": 1.0 + nrm((L, D_MODEL), 0.02),
        "ffn_post_g": 1.0 + nrm((L, D_MODEL), 0.02),
        "w_in": nrm((L, D_MODEL, N_IN), D_MODEL ** -0.5),
        "w_out": nrm((L, D_MIX, D_MODEL), D_MIX ** -0.5),
        "lam_q1": nrm((L, A_DIM), 0.1),
        "lam_k1": nrm((L, A_DIM), 0.1),
        "lam_q2": nrm((L, A_DIM), 0.1),
        "lam_k2": nrm((L, A_DIM), 0.1),
        "a_subln_g": 1.0 + nrm((L, 2 * A_DIM), 0.02),
        "b_q_norm_g": 1.0 + nrm((L, B_Q_RANK), 0.02),
        "b_w_q_up": nrm((L, B_Q_RANK, B_HEADS * (B_NOPE + B_ROPE)), B_Q_RANK ** -0.5),
        "b_kv_norm_g": 1.0 + nrm((L, B_KV_RANK), 0.02),
        "b_w_kv_up": nrm((L, B_KV_RANK, B_HEADS * (B_NOPE + B_VDIM)), B_KV_RANK ** -0.5),
        "c_mu_prev": uni((L, C_COLS), 0.0, 0.5),
        "c_mu_next": uni((L, C_COLS), 0.0, 0.5),
        "c_w0": uni((L, 2, C_WIDTH), -5.0, -1.0),
        "c_w2": nrm((L, 2, C_DECAY_LORA, C_WIDTH), 0.5 * C_DECAY_LORA ** -0.5),
        "c_a0": nrm((L, 2, C_WIDTH), 0.5),
        "c_a2": nrm((L, 2, C_ICLR_LORA, C_WIDTH), 0.5 * C_ICLR_LORA ** -0.5),
        "c_g2": nrm((L, C_GATE_LORA, C_WIDTH), C_GATE_LORA ** -0.5),
        "c_k_k": 0.85 + nrm((L, C_WIDTH), 0.05),
        "c_k_a": 1.0 + nrm((L, C_WIDTH), 0.05),
        "c_r_k": nrm((L, C_HEADS, C_DIM), 0.1),
        "c_gn_g": 1.0 + nrm((L, C_WIDTH), 0.02),
        "c_gn_b": nrm((L, C_WIDTH), 0.01),
        "ffn_w_up": nrm((L, D_MODEL, 2 * D_FF), D_MODEL ** -0.5),
        "ffn_conv_w": nrm((L, 3, 2 * D_FF), 0.5),
        "ffn_conv_b": nrm((L, 2 * D_FF), 0.01),
        "ffn_w_down": nrm((L, D_FF, D_MODEL), D_FF ** -0.5),
    }


def reference(x, c, ctx, c_ctx, ada_w, ada_b, mix_pre_g, mix_post_g, ffn_pre_g, ffn_post_g,
              w_in, w_out, lam_q1, lam_k1, lam_q2, lam_k2, a_subln_g,
              b_q_norm_g, b_w_q_up, b_kv_norm_g, b_w_kv_up,
              c_mu_prev, c_mu_next, c_w0, c_w2, c_a0, c_a2, c_g2, c_k_k, c_k_a, c_r_k, c_gn_g, c_gn_b,
              ffn_w_up, ffn_conv_w, ffn_conv_b, ffn_w_down):
    T = x.shape[1]
    ROWS = T // GRID_W
    rows = jnp.repeat(jnp.arange(ROWS, dtype=jnp.int32), GRID_W)
    cols = jnp.tile(jnp.arange(GRID_W, dtype=jnp.int32), ROWS)
    ang_a = rope_angles(rows, cols, A_DIM)
    ang_b = rope_angles(rows, cols, B_ROPE)
    c_act = jax.nn.silu(c)
    cc_act = jax.nn.silu(c_ctx)
    stacked = dict(
        ada_w=ada_w, ada_b=ada_b, mix_pre_g=mix_pre_g, mix_post_g=mix_post_g,
        ffn_pre_g=ffn_pre_g, ffn_post_g=ffn_post_g, w_in=w_in, w_out=w_out,
        lam_q1=lam_q1, lam_k1=lam_k1, lam_q2=lam_q2, lam_k2=lam_k2, a_subln_g=a_subln_g,
        b_q_norm_g=b_q_norm_g, b_w_q_up=b_w_q_up, b_kv_norm_g=b_kv_norm_g, b_w_kv_up=b_w_kv_up,
        c_mu_prev=c_mu_prev, c_mu_next=c_mu_next, c_w0=c_w0, c_w2=c_w2, c_a0=c_a0, c_a2=c_a2,
        c_g2=c_g2, c_k_k=c_k_k, c_k_a=c_k_a, c_r_k=c_r_k, c_gn_g=c_gn_g, c_gn_b=c_gn_b,
        ffn_w_up=ffn_w_up, ffn_conv_w=ffn_conv_w, ffn_conv_b=ffn_conv_b, ffn_w_down=ffn_w_down)
    xc = ctx
    for i in range(DEPTH):
        P = {name: w[i] for name, w in stacked.items()}
        lam_init = 0.8 - 0.6 * math.exp(-0.3 * i)
        x, xc = trunk_layer(x, xc, c_act, cc_act, P, lam_init, ang_a, ang_b, i < DEPTH - 1)
    return x
```

```cpp
#include <hip/hip_runtime.h>
#include <hip/hip_cooperative_groups.h>
#include <stdint.h>
#include <stdio.h>
namespace cg = cooperative_groups;

#define DI __device__ __forceinline__
typedef unsigned short u16;
typedef __attribute__((ext_vector_type(8))) short bf16x8;
typedef __attribute__((ext_vector_type(4))) short s16x4;
typedef __attribute__((ext_vector_type(16))) float f32x16;
typedef __bf16 bf2_t __attribute__((ext_vector_type(2)));
typedef float f2_t __attribute__((ext_vector_type(2)));
typedef unsigned u32x4 __attribute__((ext_vector_type(4)));
typedef unsigned u32x2 __attribute__((ext_vector_type(2)));

constexpr int D = 1024, NB = 4, SEQ = 4096, CTX = 256, TT = SEQ + CTX, R = NB * TT, MT = R / 128;
constexpr int DFF = 2816;
constexpr float LOG2E = 1.4426950408889634f;

enum { I_X = 0, I_C, I_CTX, I_CCTX, I_ADAW, I_ADAB, I_MIXPRE, I_MIXPOST, I_FFNPRE, I_FFNPOST, I_WIN, I_WOUT,
       I_LQ1, I_LK1, I_LQ2, I_LK2, I_SUBLN, I_BQG, I_BWQ, I_BKVG, I_BWKV, I_MUP, I_MUN, I_W0, I_W2, I_A0, I_A2,
       I_G2, I_KK, I_KA, I_RK, I_GNG, I_GNB, I_WUP, I_CONVW, I_CONVB, I_WDOWN, N_INPUTS };

struct Params { const float* in[N_INPUTS]; float* out; char* ws; };

constexpr size_t al(size_t x) { return (x + 255) & ~size_t(255); }
constexpr size_t OFF_MOD = 0;
constexpr size_t OFF_SCAL = OFF_MOD + al(2 * 5 * 6144 * 4);
constexpr size_t OFF_BAR = OFF_SCAL + 1024;
constexpr size_t OFF_ROPE = OFF_BAR + 16384;
constexpr size_t OFF_KR = OFF_ROPE + al(3072 * 4);
constexpr size_t OFF_XC = OFF_KR + al((size_t)R * 32 * 2);
constexpr size_t OFF_WMIX = OFF_XC + al((size_t)1024 * 1024 * 4);
constexpr size_t OFF_WT_IN = OFF_WMIX;
constexpr size_t OFF_WT_OUT = OFF_WT_IN + (size_t)3072 * 1024 * 2;
constexpr size_t OFF_WT_Q = OFF_WT_OUT + (size_t)1024 * 1024 * 2;
constexpr size_t OFF_WT_KV = OFF_WT_Q + (size_t)384 * 192 * 2;
constexpr size_t OFF_WT_W2 = OFF_WT_KV + (size_t)512 * 128 * 2;
constexpr size_t OFF_WT_A2 = OFF_WT_W2 + (size_t)2 * 256 * 64 * 2;
constexpr size_t OFF_WT_G2 = OFF_WT_A2 + (size_t)2 * 256 * 64 * 2;
constexpr size_t OFF_HB = al(OFF_WT_G2 + (size_t)256 * 128 * 2);
constexpr size_t OFF_BRAW = OFF_HB;
constexpr size_t OFF_LORA = OFF_HB + (size_t)R * 384 * 2;
constexpr size_t OFF_QA = OFF_HB + (size_t)R * 1024 * 2;
constexpr size_t OFF_KA = OFF_QA + (size_t)R * 512 * 2;
constexpr size_t OFF_VTA = OFF_KA + (size_t)R * 512 * 2;
constexpr size_t OFF_CRAW = OFF_VTA + (size_t)R * 512 * 2;
constexpr size_t OFF_DECAY = OFF_CRAW;
constexpr size_t OFF_QB = OFF_CRAW + (size_t)R * 1152 * 2;
constexpr size_t OFF_KBN = OFF_QB + (size_t)R * 384 * 2;
constexpr size_t OFF_VTB = OFF_KBN + (size_t)R * 256 * 2;
constexpr size_t OFF_AD = OFF_VTB + (size_t)R * 256 * 2;
constexpr size_t OFF_GATE = OFF_AD + (size_t)2 * R * 256 * 2;
constexpr size_t OFF_YS = OFF_GATE + (size_t)R * 256 * 2;
constexpr size_t OFF_RKVK = OFF_YS + (size_t)R * 256 * 4;
constexpr size_t OFF_H1 = OFF_RKVK;
constexpr size_t OFF_WT_UP = OFF_RKVK;
constexpr size_t OFF_WT_DOWN = OFF_WT_UP + (size_t)5632 * 1024 * 2;
constexpr size_t OFF_PART = OFF_RKVK + (size_t)R * 1024 * 2;
constexpr size_t OFF_END = OFF_PART + (size_t)4 * 1024 * 1024 * 2;
constexpr size_t OFF_RAW = OFF_QA;
constexpr size_t OFF_ACT = OFF_QA;
constexpr size_t OFF_RAW2 = OFF_ACT + (size_t)R * DFF * 2;
static_assert(OFF_RAW2 + (size_t)R * 1024 * 4 <= OFF_RKVK, "raw2 overlap");
static_assert(OFF_RAW + (size_t)R * 1024 * 4 <= OFF_QB, "raw overlap");
static_assert(OFF_WT_DOWN + (size_t)1024 * DFF * 2 <= OFF_PART, "ffn weights");
static_assert(OFF_END <= (size_t)256 * 1024 * 1024, "workspace");
static_assert((size_t)2 * R * 256 * 4 <= (size_t)R * 1152 * 2, "decay fits craw");

constexpr int SMEM_BYTES = 73728;
constexpr int TS = 133;

DI int opaque_tid() { int t = threadIdx.x; asm volatile("" : "+v"(t)); return t; }
#define TIDX opaque_tid()
DI float bf2f(u16 v) { return __uint_as_float(((unsigned)v) << 16); }
DI unsigned pack2(float a, float b) { f2_t v = {a, b}; bf2_t r = __builtin_convertvector(v, bf2_t); return __builtin_bit_cast(unsigned, r); }
DI u16 f2bf(float a) { return (u16)(pack2(a, 0.f) & 0xffffu); }
DI float lo_bf(unsigned u) { return __uint_as_float(u << 16); }
DI float hi_bf(unsigned u) { return __uint_as_float(u & 0xffff0000u); }
DI float wave_sum(float x) {
#pragma unroll
  for (int o = 32; o > 0; o >>= 1) x += __shfl_xor(x, o);
  return x;
}
template <int CTRL> DI float dpp_add(float x) {
  int v = __builtin_amdgcn_update_dpp(0, __float_as_int(x), CTRL, 0xF, 0xF, true);
  return x + __int_as_float(v);
}
DI float sum16(float x) {
  x = dpp_add<0xB1>(x); x = dpp_add<0x4E>(x); x = dpp_add<0x141>(x); x = dpp_add<0x140>(x);
  return x;
}
DI int crow(int reg, int hf) { return (reg & 3) + 8 * (reg >> 2) + 4 * hf; }
DI float sigmoidf_(float x) { return __builtin_amdgcn_rcpf(1.f + __expf(-x)); }
#define MFMA32(a, b, c) __builtin_amdgcn_mfma_f32_32x32x16_bf16((a), (b), (c), 0, 0, 0)

DI void gemm_tile(const u16* __restrict__ A, int lda, int arow0, int alo, int ahi,
                  const u16* __restrict__ Bt, int ldb, int K, char* smem) {
  const int tid = TIDX, lane = tid & 63, wave = tid >> 6, wm = wave >> 1, wn = wave & 1, l32 = lane & 31, hf = lane >> 5;
  const int srow = tid >> 3, sch = tid & 7;
  f32x16 acc[2][2];
#pragma unroll
  for (int i = 0; i < 2; ++i)
#pragma unroll
    for (int j = 0; j < 2; ++j)
#pragma unroll
      for (int r = 0; r < 16; ++r) acc[i][j][r] = 0.f;
  u32x4 ra0[4], rb0[4], ra1[4], rb1[4];
  const u32x4 z4 = {0u, 0u, 0u, 0u};
  const u16* ap[4]; const u16* bp[4]; bool av[4];
#pragma unroll
  for (int i = 0; i < 4; ++i) {
    int row = srow + 32 * i, ar = arow0 + row;
    int arc = min(max(ar, alo), ahi - 1);
    av[i] = (ar == arc);
    ap[i] = A + (size_t)arc * lda + sch * 8;
    bp[i] = Bt + (size_t)row * ldb + sch * 8;
  }
  const int nk = K >> 6;
#define G_LOAD(RA, RB, KT) \
  _Pragma("unroll") for (int i = 0; i < 4; ++i) { u32x4 va = *(const u32x4*)(ap[i] + (KT) * 64); if (!av[i]) va = z4; RA[i] = va; RB[i] = *(const u32x4*)(bp[i] + (KT) * 64); }
#define G_STORE(RA, RB, BUF) \
  _Pragma("unroll") for (int i = 0; i < 4; ++i) { int row = srow + 32 * i; \
    *(u32x4*)(smem + (BUF) * 36864 + row * 144 + sch * 16) = RA[i]; *(u32x4*)(smem + (BUF) * 36864 + 18432 + row * 144 + sch * 16) = RB[i]; }
#define G_COMPUTE(BUF) { \
    const char* sa = smem + (BUF) * 36864; const char* sb = sa + 18432; \
    _Pragma("unroll") for (int ks = 0; ks < 4; ++ks) { \
      const int ko = (ks * 16 + hf * 8) * 2; \
      bf16x8 a0 = *(const bf16x8*)(sa + (wm * 64 + l32) * 144 + ko); \
      bf16x8 a1 = *(const bf16x8*)(sa + (wm * 64 + 32 + l32) * 144 + ko); \
      bf16x8 b0 = *(const bf16x8*)(sb + (wn * 64 + l32) * 144 + ko); \
      bf16x8 b1 = *(const bf16x8*)(sb + (wn * 64 + 32 + l32) * 144 + ko); \
      acc[0][0] = MFMA32(a0, b0, acc[0][0]); acc[0][1] = MFMA32(a0, b1, acc[0][1]); \
      acc[1][0] = MFMA32(a1, b0, acc[1][0]); acc[1][1] = MFMA32(a1, b1, acc[1][1]); } }
  __syncthreads();
  G_LOAD(ra0, rb0, 0)
  if (nk > 1) { G_LOAD(ra1, rb1, 1) }
  G_STORE(ra0, rb0, 0)
  __syncthreads();
  for (int kt = 0; kt < nk; kt += 2) {
    if (kt + 2 < nk) { G_LOAD(ra0, rb0, kt + 2) }
    G_COMPUTE(0)
    if (kt + 1 < nk) { G_STORE(ra1, rb1, 1) }
    __syncthreads();
    if (kt + 1 < nk) {
      if (kt + 3 < nk) { G_LOAD(ra1, rb1, kt + 3) }
      G_COMPUTE(1)
      if (kt + 2 < nk) { G_STORE(ra0, rb0, 0) }
      __syncthreads();
    }
  }
#undef G_LOAD
#undef G_STORE
#undef G_COMPUTE
  float* T = (float*)smem;
#pragma unroll
  for (int mi = 0; mi < 2; ++mi)
#pragma unroll
    for (int ni = 0; ni < 2; ++ni)
#pragma unroll
      for (int r = 0; r < 16; ++r)
        T[(wm * 64 + mi * 32 + crow(r, hf)) * TS + wn * 64 + ni * 32 + l32] = acc[mi][ni][r];
  __syncthreads();
}

DI void store_bf16(const float* T, int jc0, int ncols, u16* out, size_t ld, int row0, int col0) {
  const int np = ncols >> 1, sh = (ncols == 128) ? 6 : 5;
  for (int e = TIDX; e < 128 * np; e += 256) {
    int i = e >> sh, j = 2 * (e & (np - 1));
    *(unsigned*)(out + (size_t)(row0 + i) * ld + col0 + j) = pack2(T[i * TS + jc0 + j], T[i * TS + jc0 + j + 1]);
  }
}
DI void store_bf16_T(const float* T, int jc0, int ncols, u16* out, int s0) {
  for (int e = TIDX; e < ncols * 64; e += 256) {
    int c = e >> 6, i2 = e & 63;
    *(unsigned*)(out + (size_t)c * TT + s0 + 2 * i2) = pack2(T[(2 * i2) * TS + jc0 + c], T[(2 * i2 + 1) * TS + jc0 + c]);
  }
}

DI int srccol(int mode, int np) {
  if (mode == 1) return np < 1888 ? np : (np < 1920 ? -1 : np - 32);
  if (mode == 2) { if (np < 256) return (np >> 6) * 96 + (np & 63); int j = np - 256; return (j >> 5) * 96 + 64 + (j & 31); }
  if (mode == 3) { int t = np >> 7, j = np & 127; return j < 64 ? t * 64 + j : DFF + t * 64 + j - 64; }
  return np;
}
DI void convert_tile(const float* __restrict__ src, int ldw, int k0, int n0, u16* __restrict__ dst, int ldd, int mode, char* smem) {
  float* T = (float*)smem;
  const int tid = TIDX;
  __syncthreads();
  {
    const int nn = tid & 63;
    const int sc = srccol(mode, n0 + nn);
#pragma unroll 4
    for (int it = 0; it < 16; ++it) {
      int kk = it * 4 + (tid >> 6);
      T[kk * 65 + nn] = sc < 0 ? 0.f : src[(size_t)(k0 + kk) * ldw + sc];
    }
  }
  __syncthreads();
#pragma unroll
  for (int it = 0; it < 2; ++it) {
    int nn = it * 32 + (tid >> 3), kc = tid & 7;
    uint4 v;
    v.x = pack2(T[(kc * 8 + 0) * 65 + nn], T[(kc * 8 + 1) * 65 + nn]);
    v.y = pack2(T[(kc * 8 + 2) * 65 + nn], T[(kc * 8 + 3) * 65 + nn]);
    v.z = pack2(T[(kc * 8 + 4) * 65 + nn], T[(kc * 8 + 5) * 65 + nn]);
    v.w = pack2(T[(kc * 8 + 6) * 65 + nn], T[(kc * 8 + 7) * 65 + nn]);
    *(uint4*)(dst + (size_t)(n0 + nn) * ldd + k0 + kc * 8) = v;
  }
}
constexpr int NCONV_MIX = 768 + 256 + 18 + 16 + 8 + 8 + 8;
DI void convert_mix_item(const Params& p, int l, int it, char* smem) {
  char* ws = p.ws;
  if (it < 768) { convert_tile(p.in[I_WIN] + (size_t)l * 1024 * 3040, 3040, (it / 48) * 64, (it % 48) * 64, (u16*)(ws + OFF_WT_IN), 1024, 1, smem); return; }
  it -= 768;
  if (it < 256) { convert_tile(p.in[I_WOUT] + (size_t)l * 1024 * 1024, 1024, (it / 16) * 64, (it % 16) * 64, (u16*)(ws + OFF_WT_OUT), 1024, 0, smem); return; }
  it -= 256;
  if (it < 18) { convert_tile(p.in[I_BWQ] + (size_t)l * 192 * 384, 384, (it / 6) * 64, (it % 6) * 64, (u16*)(ws + OFF_WT_Q), 192, 2, smem); return; }
  it -= 18;
  if (it < 16) { convert_tile(p.in[I_BWKV] + (size_t)l * 128 * 512, 512, (it / 8) * 64, (it % 8) * 64, (u16*)(ws + OFF_WT_KV), 128, 0, smem); return; }
  it -= 16;
  if (it < 8) { int d = it >> 2; convert_tile(p.in[I_W2] + (size_t)(l * 2 + d) * 64 * 256, 256, 0, (it & 3) * 64, (u16*)(ws + OFF_WT_W2) + d * 256 * 64, 64, 0, smem); return; }
  it -= 8;
  if (it < 8) { int d = it >> 2; convert_tile(p.in[I_A2] + (size_t)(l * 2 + d) * 64 * 256, 256, 0, (it & 3) * 64, (u16*)(ws + OFF_WT_A2) + d * 256 * 64, 64, 0, smem); return; }
  it -= 8;
  convert_tile(p.in[I_G2] + (size_t)l * 128 * 256, 256, (it / 4) * 64, (it % 4) * 64, (u16*)(ws + OFF_WT_G2), 128, 0, smem);
}
constexpr int NCONV_FFN = 16 * 88 + 44 * 16;
DI void convert_ffn_item(const Params& p, int l, int it, char* smem) {
  char* ws = p.ws;
  if (it < 1408) { convert_tile(p.in[I_WUP] + (size_t)l * 1024 * 5632, 5632, (it / 88) * 64, (it % 88) * 64, (u16*)(ws + OFF_WT_UP), 1024, 3, smem); return; }
  it -= 1408;
  convert_tile(p.in[I_WDOWN] + (size_t)l * DFF * 1024, 1024, (it / 16) * 64, (it % 16) * 64, (u16*)(ws + OFF_WT_DOWN), DFF, 0, smem);
}

DI void mod_item(const Params& p, int item, char* smem) {
  const int tid = TIDX, lane = tid & 63, kg = tid >> 6;
  const int l = item / 96, cb = item % 96;
  float* act = (float*)smem;
  float* red = act + 5 * 1024;
  __syncthreads();
  for (int i = tid; i < 5120; i += 256) {
    int bb = i >> 10, k = i & 1023;
    float v = bb < 4 ? p.in[I_C][bb * 1024 + k] : p.in[I_CCTX][k];
    act[i] = v / (1.f + __expf(-v));
  }
  __syncthreads();
  float a0 = 0, a1 = 0, a2 = 0, a3 = 0, a4 = 0;
  const float* W = p.in[I_ADAW] + ((size_t)l * 1024 + kg * 256) * 6144 + cb * 64 + lane;
  const float* ac = act + kg * 256;
#pragma unroll 32
  for (int k = 0; k < 256; ++k) {
    float w = W[(size_t)k * 6144];
    a0 += ac[k] * w; a1 += ac[1024 + k] * w; a2 += ac[2048 + k] * w; a3 += ac[3072 + k] * w; a4 += ac[4096 + k] * w;
  }
  red[(kg * 5 + 0) * 64 + lane] = a0; red[(kg * 5 + 1) * 64 + lane] = a1; red[(kg * 5 + 2) * 64 + lane] = a2;
  red[(kg * 5 + 3) * 64 + lane] = a3; red[(kg * 5 + 4) * 64 + lane] = a4;
  __syncthreads();
  float* mod = (float*)(p.ws + OFF_MOD);
  for (int idx = tid; idx < 320; idx += 256) {
    int bb = idx >> 6, c = idx & 63;
    float s = red[(0 * 5 + bb) * 64 + c] + red[(1 * 5 + bb) * 64 + c] + red[(2 * 5 + bb) * 64 + c] + red[(3 * 5 + bb) * 64 + c];
    mod[(size_t)(l * 5 + bb) * 6144 + cb * 64 + c] = s + p.in[I_ADAB][l * 6144 + cb * 64 + c];
  }
}
DI void misc_setup(const Params& p) {
  const int tid = TIDX;
  float* rope = (float*)(p.ws + OFF_ROPE);
  for (int i = tid; i < 1024; i += 256) {
    int pos = i >> 4, f = i & 15;
    float inv = exp2f(-(float)f * (13.287712379549449f / 16.f));
    float a = (float)pos * inv;
    rope[i] = cosf(a); rope[1024 + i] = sinf(a);
  }
  for (int i = tid; i < 512; i += 256) {
    int pos = i >> 3, f = i & 7;
    float inv = exp2f(-(float)f * (13.287712379549449f / 8.f));
    float a = (float)pos * inv;
    rope[2048 + i] = cosf(a); rope[2560 + i] = sinf(a);
  }
  if (tid < 16) ((int*)(p.ws + OFF_SCAL + 64))[tid] = 0;
  if (tid < 2) {
    int l = tid;
    float s1 = 0, s2 = 0;
    for (int i = 0; i < 64; ++i) {
      s1 += p.in[I_LQ1][l * 64 + i] * p.in[I_LK1][l * 64 + i];
      s2 += p.in[I_LQ2][l * 64 + i] * p.in[I_LK2][l * 64 + i];
    }
    float lam_init = 0.8f - 0.6f * expf(-0.3f * (float)l);
    ((float*)(p.ws + OFF_SCAL))[l] = expf(s1) - expf(s2) + lam_init;
    ((float*)(p.ws + OFF_SCAL))[2 + l] = lam_init;
  }
}

DI void norm_phase(const Params& p, int post, int lpost, int pre, int lpre, bool xin_input, bool skip_ctx) {
  const int lane = TIDX & 63, wave = TIDX >> 6;
  const float* mod = (const float*)(p.ws + OFF_MOD);
  for (int row = blockIdx.x * 4 + wave; row < R; row += gridDim.x * 4) {
    const int b = row / TT, s = row % TT;
    const bool isctx = s < CTX;
    if (isctx && skip_ctx) continue;
    const int bb = isctx ? 4 : b;
    const float* xin;
    float* xst = isctx ? (float*)(p.ws + OFF_XC) + (size_t)(b * CTX + s) * D : p.out + (size_t)(b * SEQ + s - CTX) * D;
    if (xin_input) xin = isctx ? p.in[I_CTX] + (size_t)(b * CTX + s) * D : p.in[I_X] + (size_t)(b * SEQ + s - CTX) * D;
    else xin = xst;
    float4 x[4];
#pragma unroll
    for (int i = 0; i < 4; ++i) x[i] = *(const float4*)(xin + (i * 64 + lane) * 4);
    if (post) {
      const u16* raw = (const u16*)(p.ws + (post == 1 ? OFF_RAW : OFF_RAW2)) + (size_t)row * D;
      const float* pg = p.in[post == 1 ? I_MIXPOST : I_FFNPOST] + lpost * D;
      const float* gt = mod + (size_t)(lpost * 5 + bb) * 6144 + (post == 1 ? 2048 : 5120);
      float4 o[4];
      float ss = 0.f;
#pragma unroll
      for (int i = 0; i < 4; ++i) {
        if (isctx) {
          const u16* pp = (const u16*)(p.ws + OFF_PART) + (size_t)(b * CTX + s) * D + (i * 64 + lane) * 4;
          o[i] = make_float4(0.f, 0.f, 0.f, 0.f);
#pragma unroll
          for (int q = 0; q < 4; ++q) {
            const uint2 ru = *(const uint2*)(pp + (size_t)q * 1024 * 1024);
            o[i].x += lo_bf(ru.x); o[i].y += hi_bf(ru.x); o[i].z += lo_bf(ru.y); o[i].w += hi_bf(ru.y);
          }
        } else {
          const uint2 ru = *(const uint2*)(raw + (i * 64 + lane) * 4);
          o[i] = make_float4(lo_bf(ru.x), hi_bf(ru.x), lo_bf(ru.y), hi_bf(ru.y));
        }
        ss += o[i].x * o[i].x + o[i].y * o[i].y + o[i].z * o[i].z + o[i].w * o[i].w;
      }
      ss = wave_sum(ss);
      const float rinv = rsqrtf(ss * (1.f / D) + 1e-6f);
#pragma unroll
      for (int i = 0; i < 4; ++i) {
        float4 g = *(const float4*)(pg + (i * 64 + lane) * 4);
        float4 t = *(const float4*)(gt + (i * 64 + lane) * 4);
        x[i].x += t.x * (o[i].x * rinv * g.x); x[i].y += t.y * (o[i].y * rinv * g.y);
        x[i].z += t.z * (o[i].z * rinv * g.z); x[i].w += t.w * (o[i].w * rinv * g.w);
        *(float4*)(xst + (i * 64 + lane) * 4) = x[i];
      }
    }
    if (pre) {
      const float* pg = p.in[pre == 1 ? I_FFNPRE : I_MIXPRE] + lpre * D;
      const float* sc = mod + (size_t)(lpre * 5 + bb) * 6144 + (pre == 1 ? 4096 : 1024);
      const float* sh = mod + (size_t)(lpre * 5 + bb) * 6144 + (pre == 1 ? 3072 : 0);
      u16* hout = (u16*)(p.ws + (pre == 1 ? OFF_HB : OFF_H1)) + (size_t)row * D;
      float ss = 0.f;
#pragma unroll
      for (int i = 0; i < 4; ++i) ss += x[i].x * x[i].x + x[i].y * x[i].y + x[i].z * x[i].z + x[i].w * x[i].w;
      ss = wave_sum(ss);
      const float rinv = rsqrtf(ss * (1.f / D) + 1e-6f);
#pragma unroll
      for (int i = 0; i < 4; ++i) {
        float4 g = *(const float4*)(pg + (i * 64 + lane) * 4);
        float4 c4 = *(const float4*)(sc + (i * 64 + lane) * 4);
        float4 h4 = *(const float4*)(sh + (i * 64 + lane) * 4);
        uint2 v;
        v.x = pack2(x[i].x * rinv * g.x * (1.f + c4.x) + h4.x, x[i].y * rinv * g.y * (1.f + c4.y) + h4.y);
        v.y = pack2(x[i].z * rinv * g.z * (1.f + c4.z) + h4.z, x[i].w * rinv * g.w * (1.f + c4.w) + h4.w);
        *(uint2*)(hout + (i * 64 + lane) * 4) = v;
      }
    }
  }
}


#define XCD_TILE_LOOP(MTN, NTN, PN_) \
  for (int x_ = blockIdx.x & 7, nsl_ = gridDim.x >> 3, mlo_ = x_ * (MTN) / 8, mtx_ = (x_ + 1) * (MTN) / 8 - mlo_, q_ = blockIdx.x >> 3; \
       q_ < mtx_ * (NTN); q_ += nsl_)
#define XCD_TILE_DECODE(NTN, PN_, MT_, NT_) \
  int MT_, NT_; { int p_ = q_ / (mtx_ * (PN_)); int rem_ = q_ - p_ * mtx_ * (PN_); int wp_ = min((PN_), (NTN) - p_ * (PN_)); \
    MT_ = mlo_ + rem_ / wp_; NT_ = p_ * (PN_) + rem_ % wp_; }

DI void rope_store_A(const Params& p, const float* T, u16* out, int row0, int col0, float scale) {
  const float* cosA = (const float*)(p.ws + OFF_ROPE);
  const float* sinA = cosA + 1024;
  for (int e = TIDX; e < 128 * 64; e += 256) {
    int i = e >> 6, j = 2 * (e & 63);
    int s = (row0 + i) % TT;
    float v0 = T[i * TS + j], v1 = T[i * TS + j + 1];
    if (s >= CTX) {
      int t = s - CTX, d = j & 63;
      int pos = (d < 32) ? (t >> 6) : (t & 63);
      int f = d & 15;
      float c0 = cosA[pos * 16 + f], s0 = sinA[pos * 16 + f], c1 = cosA[pos * 16 + f + 1], s1 = sinA[pos * 16 + f + 1];
      float p0 = T[i * TS + (j ^ 16)], p1 = T[i * TS + ((j + 1) ^ 16)];
      if (d & 16) { v0 = v0 * c0 + p0 * s0; v1 = v1 * c1 + p1 * s1; }
      else { v0 = v0 * c0 - p0 * s0; v1 = v1 * c1 - p1 * s1; }
    }
    *(unsigned*)(out + (size_t)(row0 + i) * 512 + col0 + j) = pack2(v0 * scale, v1 * scale);
  }
}
DI void phase_gemm_in(const Params& p, char* smem) {
  char* ws = p.ws;
  XCD_TILE_LOOP(MT, 24, 8) {
    XCD_TILE_DECODE(24, 8, mt, nt)
    const int row0 = mt * 128;
    gemm_tile((const u16*)(ws + OFF_H1), 1024, row0, 0, R, (const u16*)(ws + OFF_WT_IN) + (size_t)nt * 128 * 1024, 1024, 1024, smem);
    const float* T = (const float*)smem;
    if (nt < 4) rope_store_A(p, T, (u16*)(ws + OFF_QA), row0, nt * 128, 0.125f * LOG2E);
    else if (nt < 8) rope_store_A(p, T, (u16*)(ws + OFF_KA), row0, (nt - 4) * 128, 1.f);
    else if (nt < 12) { int b = row0 / TT, s0 = row0 % TT; store_bf16_T(T, 0, 128, (u16*)(ws + OFF_VTA) + ((size_t)b * 512 + (nt - 8) * 128) * TT, s0); }
    else if (nt < 15) store_bf16(T, 0, 128, (u16*)(ws + OFF_BRAW), 384, row0, (nt - 12) * 128);
    else store_bf16(T, 0, 128, (u16*)(ws + OFF_CRAW), 1152, row0, (nt - 15) * 128);
  }
}

DI void phase_prep(const Params& p, int l) {
  char* ws = p.ws;
  const int lane = TIDX & 63, wave = TIDX >> 6;
  const float* cosB = (const float*)(ws + OFF_ROPE) + 2048;
  const float* sinB = cosB + 512;
  for (int row = blockIdx.x * 4 + wave; row < R; row += gridDim.x * 4) {
    const int s = row % TT;
    u16* br = (u16*)(ws + OFF_BRAW) + (size_t)row * 384;
    {
      float v0 = bf2f(br[lane]), v1 = bf2f(br[64 + lane]), v2 = bf2f(br[128 + lane]);
      float w0 = bf2f(br[192 + lane]), w1 = bf2f(br[256 + lane]);
      float kr = lane < 32 ? bf2f(br[320 + lane]) : 0.f;
      float ssq = wave_sum(v0 * v0 + v1 * v1 + v2 * v2);
      float ssk = wave_sum(w0 * w0 + w1 * w1);
      float rq = rsqrtf(ssq * (1.f / 192.f) + 1e-6f), rk = rsqrtf(ssk * (1.f / 128.f) + 1e-6f);
      const float* gq = p.in[I_BQG] + l * 192;
      const float* gk = p.in[I_BKVG] + l * 128;
      br[lane] = f2bf(v0 * rq * gq[lane]); br[64 + lane] = f2bf(v1 * rq * gq[64 + lane]); br[128 + lane] = f2bf(v2 * rq * gq[128 + lane]);
      br[192 + lane] = f2bf(w0 * rk * gk[lane]); br[256 + lane] = f2bf(w1 * rk * gk[64 + lane]);
      float kp = __shfl_xor(kr, 8);
      if (s >= CTX) {
        int t = s - CTX, d = lane & 31;
        int pos = (d < 16) ? (t >> 6) : (t & 63);
        int f = d & 7;
        float c = cosB[pos * 8 + f], sn = sinB[pos * 8 + f];
        kr = (d & 8) ? kr * c + kp * sn : kr * c - kp * sn;
      }
      if (lane < 32) ((u16*)(ws + OFF_KR))[(size_t)row * 32 + lane] = f2bf(kr);
    }
    const bool hasprev = (s != 0 && s != CTX), hasnext = (s != CTX - 1 && s != TT - 1);
    const u16* cr = (const u16*)(ws + OFF_CRAW) + (size_t)row * 1152;
    u16* rk4 = (u16*)(ws + OFF_RKVK);
    u16* lora = (u16*)(ws + OFF_LORA) + (size_t)row * 384;
#pragma unroll
    for (int it = 0; it < 5; ++it) {
      const int g = it * 64 + lane;
      if (g < 288) {
        const int col = g * 4;
        uint2 cu = *(const uint2*)(cr + col);
        uint2 pu = hasprev ? *(const uint2*)(cr - 1152 + col) : make_uint2(0, 0);
        uint2 nu = hasnext ? *(const uint2*)(cr + 1152 + col) : make_uint2(0, 0);
        float4 mp = *(const float4*)(p.in[I_MUP] + l * 1152 + col);
        float4 mn = *(const float4*)(p.in[I_MUN] + l * 1152 + col);
        float c0 = lo_bf(cu.x), c1 = hi_bf(cu.x), c2 = lo_bf(cu.y), c3 = hi_bf(cu.y);
        float x0 = c0 + mp.x * (lo_bf(pu.x) - c0) + mn.x * (lo_bf(nu.x) - c0);
        float x1 = c1 + mp.y * (hi_bf(pu.x) - c1) + mn.y * (hi_bf(nu.x) - c1);
        float x2 = c2 + mp.z * (lo_bf(pu.y) - c2) + mn.z * (lo_bf(nu.y) - c2);
        float x3 = c3 + mp.w * (hi_bf(pu.y) - c3) + mn.w * (hi_bf(nu.y) - c3);
        if (it < 3) {
          const int c = col - it * 256;
          *(uint2*)(rk4 + (size_t)it * R * 256 + (size_t)row * 256 + c) = make_uint2(pack2(x0, x1), pack2(x2, x3));
          if (it == 1) {
            float4 kk = *(const float4*)(p.in[I_KK] + l * 256 + c);
            float k0 = x0 * kk.x, k1 = x1 * kk.y, k2 = x2 * kk.z, k3 = x3 * kk.w;
            float ss = k0 * k0 + k1 * k1 + k2 * k2 + k3 * k3;
            ss += __shfl_xor(ss, 1); ss += __shfl_xor(ss, 2); ss += __shfl_xor(ss, 4); ss += __shfl_xor(ss, 8);
            float inv = 1.f / fmaxf(sqrtf(ss), 1e-12f);
            *(uint2*)(rk4 + (size_t)3 * R * 256 + (size_t)row * 256 + c) = make_uint2(pack2(k0 * inv, k1 * inv), pack2(k2 * inv, k3 * inv));
          }
        } else if (it == 3) {
          const int c = col - 768;
          if (c < 128) {
            x0 = 1.f - 2.f / (__expf(2.f * x0) + 1.f); x1 = 1.f - 2.f / (__expf(2.f * x1) + 1.f);
            x2 = 1.f - 2.f / (__expf(2.f * x2) + 1.f); x3 = 1.f - 2.f / (__expf(2.f * x3) + 1.f);
          }
          *(uint2*)(lora + c) = make_uint2(pack2(x0, x1), pack2(x2, x3));
        } else {
          const int c = col - 1024;
          *(uint2*)(lora + 256 + c) = make_uint2(pack2(sigmoidf_(x0), sigmoidf_(x1)), pack2(sigmoidf_(x2), sigmoidf_(x3)));
        }
      }
    }
    *(float4*)((float*)(ws + OFF_YS) + (size_t)row * 256 + lane * 4) = make_float4(0.f, 0.f, 0.f, 0.f);
  }
}

DI void phase_small_gemms(const Params& p, int l, char* smem) {
  char* ws = p.ws;
  const float* cosB = (const float*)(ws + OFF_ROPE) + 2048;
  const float* sinB = cosB + 512;
  const float scaleB = 0.10206207261596575f * LOG2E;
  XCD_TILE_LOOP(MT, 17, 17) {
    XCD_TILE_DECODE(17, 17, mt, g)
    const int row0 = mt * 128;
    const float* T = (const float*)smem;
    if (g < 3) {
      gemm_tile((const u16*)(ws + OFF_BRAW), 384, row0, 0, R, (const u16*)(ws + OFF_WT_Q) + (size_t)g * 128 * 192, 192, 192, smem);
      u16* qb = (u16*)(ws + OFF_QB);
      for (int e = TIDX; e < 128 * 64; e += 256) {
        int i = e >> 6, j = 2 * (e & 63);
        float v0 = T[i * TS + j], v1 = T[i * TS + j + 1];
        int oc;
        if (g < 2) { int np = g * 128 + j; oc = (np >> 6) * 96 + (np & 63); }
        else {
          int h = j >> 5, dr = j & 31;
          oc = h * 96 + 64 + dr;
          int s = (row0 + i) % TT;
          if (s >= CTX) {
            int tt = s - CTX;
            int pos = (dr < 16) ? (tt >> 6) : (tt & 63);
            int f = dr & 7;
            float c0 = cosB[pos * 8 + f], s0 = sinB[pos * 8 + f], c1 = cosB[pos * 8 + f + 1], s1 = sinB[pos * 8 + f + 1];
            float p0 = T[i * TS + (j ^ 8)], p1 = T[i * TS + ((j + 1) ^ 8)];
            if (dr & 8) { v0 = v0 * c0 + p0 * s0; v1 = v1 * c1 + p1 * s1; }
            else { v0 = v0 * c0 - p0 * s0; v1 = v1 * c1 - p1 * s1; }
          }
        }
        *(unsigned*)(qb + (size_t)(row0 + i) * 384 + oc) = pack2(v0 * scaleB, v1 * scaleB);
      }
    } else if (g < 7) {
      const int h = g - 3;
      gemm_tile((const u16*)(ws + OFF_BRAW) + 192, 384, row0, 0, R, (const u16*)(ws + OFF_WT_KV) + (size_t)h * 128 * 128, 128, 128, smem);
      store_bf16(T, 0, 64, (u16*)(ws + OFF_KBN), 256, row0, h * 64);
      int b = row0 / TT, s0 = row0 % TT;
      store_bf16_T(T, 64, 64, (u16*)(ws + OFF_VTB) + ((size_t)b * 256 + h * 64) * TT, s0);
    } else if (g < 11) {
      const int d = (g - 7) >> 1, nt = (g - 7) & 1;
      gemm_tile((const u16*)(ws + OFF_LORA) + d * 64, 384, row0, 0, R, (const u16*)(ws + OFF_WT_W2) + (size_t)(d * 256 + nt * 128) * 64, 64, 64, smem);
      float* dec = (float*)(ws + OFF_DECAY) + (size_t)d * R * 256;
      const float* w0 = p.in[I_W0] + (l * 2 + d) * 256 + nt * 128;
      for (int e = TIDX; e < 128 * 128; e += 256) {
        int i = e >> 7, j = e & 127;
        dec[(size_t)(row0 + i) * 256 + nt * 128 + j] = __expf(-0.6065306597126334f * sigmoidf_(w0[j] + T[i * TS + j]));
      }
    } else if (g < 15) {
      const int d = (g - 11) >> 1, nt = (g - 11) & 1;
      gemm_tile((const u16*)(ws + OFF_LORA) + 128 + d * 64, 384, row0, 0, R, (const u16*)(ws + OFF_WT_A2) + (size_t)(d * 256 + nt * 128) * 64, 64, 64, smem);
      u16* ad = (u16*)(ws + OFF_AD) + (size_t)d * R * 256;
      const float* a0 = p.in[I_A0] + (l * 2 + d) * 256 + nt * 128;
      for (int e = TIDX; e < 128 * 64; e += 256) {
        int i = e >> 6, j = 2 * (e & 63);
        *(unsigned*)(ad + (size_t)(row0 + i) * 256 + nt * 128 + j) =
            pack2(sigmoidf_(a0[j] + T[i * TS + j]), sigmoidf_(a0[j + 1] + T[i * TS + j + 1]));
      }
    } else {
      const int nt = g - 15;
      gemm_tile((const u16*)(ws + OFF_LORA) + 256, 384, row0, 0, R, (const u16*)(ws + OFF_WT_G2) + (size_t)nt * 128 * 128, 128, 128, smem);
      store_bf16(T, 0, 128, (u16*)(ws + OFF_GATE), 256, row0, nt * 128);
    }
  }
}

DI float scan_chunk(const float* Vb, int sl, int st, f2_t& S01, f2_t& S23) {
  float4 w4 = *(const float4*)(Vb + sl * 4), kd4 = *(const float4*)(Vb + 64 + sl * 4), a4 = *(const float4*)(Vb + 128 + sl * 4);
  float4 b4 = *(const float4*)(Vb + 192 + sl * 4), r4 = *(const float4*)(Vb + 256 + sl * 4);
  float vv = Vb[320 + st];
  float ykeep = 0.f;
#pragma unroll
  for (int s2 = 0; s2 < 16; ++s2) {
    const float4 cw = w4, ckd = kd4, ca = a4, cb = b4, cr = r4; const float cv = vv;
    if (s2 + 1 < 16) {
      const float* P = Vb + (s2 + 1) * 336;
      w4 = *(const float4*)(P + sl * 4); kd4 = *(const float4*)(P + 64 + sl * 4); a4 = *(const float4*)(P + 128 + sl * 4);
      b4 = *(const float4*)(P + 192 + sl * 4); r4 = *(const float4*)(P + 256 + sl * 4); vv = P[320 + st];
    }
    const f2_t v2 = {cv, cv};
    const f2_t pre01 = __builtin_elementwise_fma(v2, (f2_t){ckd.x, ckd.y}, S01 * (f2_t){cw.x, cw.y});
    const f2_t pre23 = __builtin_elementwise_fma(v2, (f2_t){ckd.z, ckd.w}, S23 * (f2_t){cw.z, cw.w});
    f2_t sp = S01 * (f2_t){ca.x, ca.y};
    sp = __builtin_elementwise_fma(S23, (f2_t){ca.z, ca.w}, sp);
    float sa = sum16(sp.x + sp.y);
    const f2_t sa2 = {sa, sa};
    S01 = __builtin_elementwise_fma(sa2, (f2_t){cb.x, cb.y}, pre01);
    S23 = __builtin_elementwise_fma(sa2, (f2_t){cb.z, cb.w}, pre23);
    f2_t yp = S01 * (f2_t){cr.x, cr.y};
    yp = __builtin_elementwise_fma(S23, (f2_t){cr.z, cr.w}, yp);
    float y = sum16(yp.x + yp.y);
    ykeep = (s2 == sl) ? y : ykeep;
  }
  return ykeep;
}

typedef float f32x4v __attribute__((ext_vector_type(4)));
struct ScanStg { u32x2 r, k, kk, a; f32x4v d; u16 v; };
DI void scan_item(const Params& p, int l, int item, char* smem) {
  char* ws = p.ws;
  const int tid = TIDX;
  const int dir = item & 1, rg = (item >> 1) & 3, bh = item >> 3, b = bh >> 2, h = bh & 3;
  const int st = tid >> 4, sl = tid & 15;
  const u16* RB = (const u16*)(ws + OFF_RKVK);
  const u16* KB2 = RB + (size_t)R * 256;
  const u16* VB2 = KB2 + (size_t)R * 256;
  const u16* KKB = VB2 + (size_t)R * 256;
  const u16* AD = (const u16*)(ws + OFF_AD) + (size_t)dir * R * 256;
  const float* DEC = (const float*)(ws + OFF_DECAY) + (size_t)dir * R * 256;
  float* YS = (float*)(ws + OFF_YS);
  const float4 ka = *(const float4*)(p.in[I_KA] + l * 256 + h * 64 + sl * 4);
  const int colk = h * 64 + sl * 4, colv = h * 64 + rg * 16 + sl;
  f2_t S01 = {0.f, 0.f}, S23 = {0.f, 0.f};
  constexpr int NCH = TT / 16;
  __builtin_amdgcn_s_setprio(3);
  auto tok_of = [&](int j) -> int { return dir == 0 ? j : (j < CTX ? CTX - 1 - j : TT + CTX - 1 - j); };
#define SC_LOAD(S, CH) { const size_t ro = (size_t)(b * TT + tok_of((CH) * 16 + st)) * 256; \
    S.r = *(const u32x2*)(RB + ro + colk); S.k = *(const u32x2*)(KB2 + ro + colk); S.kk = *(const u32x2*)(KKB + ro + colk); \
    S.a = *(const u32x2*)(AD + ro + colk); S.d = *(const f32x4v*)(DEC + ro + colk); S.v = VB2[ro + colv]; }
#define SC_BODY(S, CH, YK) { \
    { float* V = (float*)(smem + ((CH) & 1) * 21504) + st * 336; \
      float k0 = lo_bf(S.k.x), k1 = hi_bf(S.k.x), k2 = lo_bf(S.k.y), k3 = hi_bf(S.k.y); \
      float a0 = lo_bf(S.a.x), a1 = hi_bf(S.a.x), a2 = lo_bf(S.a.y), a3 = hi_bf(S.a.y); \
      float q0 = lo_bf(S.kk.x), q1 = hi_bf(S.kk.x), q2 = lo_bf(S.kk.y), q3 = hi_bf(S.kk.y); \
      *(f32x4v*)(V + 0 * 64 + sl * 4) = S.d; \
      *(float4*)(V + 1 * 64 + sl * 4) = make_float4(k0 * (1.f + (a0 - 1.f) * ka.x), k1 * (1.f + (a1 - 1.f) * ka.y), \
                                                     k2 * (1.f + (a2 - 1.f) * ka.z), k3 * (1.f + (a3 - 1.f) * ka.w)); \
      *(float4*)(V + 2 * 64 + sl * 4) = make_float4(-q0, -q1, -q2, -q3); \
      *(float4*)(V + 3 * 64 + sl * 4) = make_float4(q0 * a0, q1 * a1, q2 * a2, q3 * a3); \
      *(float4*)(V + 4 * 64 + sl * 4) = make_float4(lo_bf(S.r.x), hi_bf(S.r.x), lo_bf(S.r.y), hi_bf(S.r.y)); \
      V[320 + sl] = bf2f(S.v); } \
    __syncthreads(); \
    SC_LOAD(S, min((CH) + 4, NCH - 1))     \
    YK = scan_chunk((const float*)(smem + ((CH) & 1) * 21504), sl, st, S01, S23); }
  ScanStg g0, g1, g2, g3;
  __syncthreads();
  SC_LOAD(g0, 0) asm volatile("" ::: "memory");
  SC_LOAD(g1, 1) asm volatile("" ::: "memory");
  SC_LOAD(g2, 2) asm volatile("" ::: "memory");
  SC_LOAD(g3, 3) asm volatile("" ::: "memory");
#define SC_YADD(CH, YK) unsafeAtomicAdd(YS + (size_t)(b * TT + tok_of((CH) * 16 + sl)) * 256 + h * 64 + rg * 16 + st, YK);
  for (int ch = 0; ch < NCH; ch += 4) {
    float y0, y1, y2, y3;
    SC_BODY(g0, ch, y0) SC_BODY(g1, ch + 1, y1) SC_BODY(g2, ch + 2, y2) SC_BODY(g3, ch + 3, y3)
    SC_YADD(ch, y0) SC_YADD(ch + 1, y1) SC_YADD(ch + 2, y2) SC_YADD(ch + 3, y3)
  }
#undef SC_YADD
#undef SC_LOAD
#undef SC_BODY
  __builtin_amdgcn_s_setprio(0);
}

template <bool DIFF>
DI void attn_item(const Params& p, int l, int item, char* smem) {
  char* ws = p.ws;
  constexpr int DQK = DIFF ? 64 : 96, KS = DQK / 16, DB = DIFF ? 4 : 2;
  constexpr int KROWB = DIFF ? 144 : 208;
  constexpr int KBYTES = DIFF ? 2 * 64 * 144 : 64 * 208;
  constexpr int VROWS = DIFF ? 128 : 64;
  constexpr int BUFB = KBYTES + VROWS * 144;
  constexpr int NCHK = DIFF ? 8 : 5;
  constexpr int QPB = DIFF ? 64 : 128;
  constexpr int NQB = TT / QPB, CTXB = CTX / QPB;
  const int tid = TIDX, lane = tid & 63, wave = tid >> 6, l32 = lane & 31, hf = lane >> 5;
  const int nact = (l == 0) ? NQB : NQB - CTXB;
  const int bh = item / nact, qb = item % nact + ((l == 0) ? 0 : CTXB);
  const int b = bh >> 2, h = bh & 3;
  const int q0 = qb * QPB;
  const int nkt = ((q0 < CTX) ? CTX : TT) / 64;
  const int m = DIFF ? (wave >> 1) : 0;
  const int qtok = q0 + (DIFF ? (wave & 1) : wave) * 32 + l32;
  const size_t qrow = (size_t)b * TT + qtok;

  bf16x8 qf[KS];
#pragma unroll
  for (int ks = 0; ks < KS; ++ks) {
    if (DIFF) qf[ks] = *(const bf16x8*)((const u16*)(ws + OFF_QA) + qrow * 512 + (h * 2 + m) * 64 + ks * 16 + hf * 8);
    else qf[ks] = *(const bf16x8*)((const u16*)(ws + OFF_QB) + qrow * 384 + h * 96 + ks * 16 + hf * 8);
  }
  f32x16 O[DB];
#pragma unroll
  for (int d = 0; d < DB; ++d)
#pragma unroll
    for (int r = 0; r < 16; ++r) O[d][r] = 0.f;
  float m_run = 0.f, l_run = 0.f;

  u32x4 stg[NCHK];
#define ATT_GLOAD(KT) \
  _Pragma("unroll") for (int i = 0; i < NCHK; ++i) { \
    const int c = tid + 256 * i; \
    const u16* src; \
    if (DIFF) { \
      if (i < 4) { int map = c >> 9, key = (c >> 3) & 63, chn = c & 7; \
        src = (const u16*)(ws + OFF_KA) + ((size_t)b * TT + (KT) * 64 + key) * 512 + (h * 2 + map) * 64 + chn * 8; } \
      else { int c2 = c - 1024, e = c2 >> 3, chn = c2 & 7; \
        src = (const u16*)(ws + OFF_VTA) + ((size_t)b * 512 + h * 128 + e) * TT + (KT) * 64 + chn * 8; } \
    } else { \
      if (i < 3) { int key = c / 12, chn = c % 12; \
        size_t kr = (size_t)b * TT + (KT) * 64 + key; \
        src = chn < 8 ? (const u16*)(ws + OFF_KBN) + kr * 256 + h * 64 + chn * 8 : (const u16*)(ws + OFF_KR) + kr * 32 + (chn - 8) * 8; } \
      else { int c2 = c - 768, e = c2 >> 3, chn = c2 & 7; \
        src = (const u16*)(ws + OFF_VTB) + ((size_t)b * 256 + h * 64 + e) * TT + (KT) * 64 + chn * 8; } \
    } \
    stg[i] = *(const u32x4*)src; \
  }
#define ATT_SSTORE(BUF) \
  _Pragma("unroll") for (int i = 0; i < NCHK; ++i) { \
    const int c = tid + 256 * i; \
    int off; \
    if (DIFF) { \
      if (i < 4) { int map = c >> 9, key = (c >> 3) & 63, chn = c & 7; int krow = (key & ~12) | ((key & 4) << 1) | ((key & 8) >> 1); off = map * 9216 + krow * 144 + chn * 16; } \
      else { int c2 = c - 1024, e = c2 >> 3, chn = c2 & 7; off = KBYTES + e * 144 + chn * 16; } \
    } else { \
      if (i < 3) { int key = c / 12, chn = c % 12; int krow = (key & ~12) | ((key & 4) << 1) | ((key & 8) >> 1); off = krow * 208 + chn * 16; } \
      else { int c2 = c - 768, e = c2 >> 3, chn = c2 & 7; off = KBYTES + e * 144 + chn * 16; } \
    } \
    *(u32x4*)(smem + (BUF) * BUFB + off) = stg[i]; \
  }
  __syncthreads();
  ATT_GLOAD(0)
  ATT_SSTORE(0)
  __syncthreads();
  for (int kt = 0; kt < nkt; ++kt) {
    if (kt + 1 < nkt) { ATT_GLOAD(kt + 1) }
    const char* sk = smem + (kt & 1) * BUFB + (DIFF ? m * 9216 : 0);
    const char* sv = smem + (kt & 1) * BUFB + KBYTES;
    f32x16 sc[2];
#pragma unroll
    for (int kb = 0; kb < 2; ++kb) {
#pragma unroll
      for (int r = 0; r < 16; ++r) sc[kb][r] = -m_run;
#pragma unroll
      for (int ks = 0; ks < KS; ++ks) {
        bf16x8 a = *(const bf16x8*)(sk + (kb * 32 + l32) * KROWB + (ks * 16 + hf * 8) * 2);
        sc[kb] = MFMA32(a, qf[ks], sc[kb]);
      }
    }
    float mx = sc[0][0];
#pragma unroll
    for (int r = 0; r < 16; ++r) { mx = fmaxf(mx, sc[0][r]); mx = fmaxf(mx, sc[1][r]); }
    mx = fmaxf(mx, __shfl_xor(mx, 32));
    if (kt == 0 || __builtin_amdgcn_ballot_w64(mx > 8.f) != 0) {
      const float delta = (kt == 0) ? mx : fmaxf(mx, 0.f);
      const float alpha = (kt == 0) ? 1.f : __builtin_amdgcn_exp2f(-delta);
      m_run += delta;
      l_run *= alpha;
#pragma unroll
      for (int d = 0; d < DB; ++d)
#pragma unroll
        for (int r = 0; r < 16; ++r) O[d][r] *= alpha;
#pragma unroll
      for (int kb = 0; kb < 2; ++kb)
#pragma unroll
        for (int r = 0; r < 16; ++r) sc[kb][r] -= delta;
    }
    float psum = 0.f;
#pragma unroll
    for (int kb = 0; kb < 2; ++kb)
#pragma unroll
      for (int r = 0; r < 16; ++r) { float e = __builtin_amdgcn_exp2f(sc[kb][r]); sc[kb][r] = e; psum += e; }
    l_run += psum;
    bf16x8 pf[4];
#pragma unroll
    for (int s2 = 0; s2 < 4; ++s2) {
      const int kb = s2 >> 1, r0 = (s2 & 1) * 8;
      u32x4 u = {pack2(sc[kb][r0 + 0], sc[kb][r0 + 1]), pack2(sc[kb][r0 + 2], sc[kb][r0 + 3]),
                 pack2(sc[kb][r0 + 4], sc[kb][r0 + 5]), pack2(sc[kb][r0 + 6], sc[kb][r0 + 7])};
      pf[s2] = __builtin_bit_cast(bf16x8, u);
    }
#pragma unroll
    for (int d = 0; d < DB; ++d) {
#pragma unroll
      for (int s2 = 0; s2 < 4; ++s2) {
        const int kbase = (s2 >> 1) * 32 + (s2 & 1) * 16 + 8 * hf;
        const bf16x8 vf = *(const bf16x8*)(sv + (d * 32 + l32) * 144 + kbase * 2);
        O[d] = MFMA32(vf, pf[s2], O[d]);
      }
    }
    if (kt + 1 < nkt) { ATT_SSTORE((kt + 1) & 1) }
    __syncthreads();
  }
  const float ltot = l_run + __shfl_xor(l_run, 32);
  const float inv = 1.f / ltot;
  u16* cc = (u16*)(ws + OFF_HB) + qrow * 1024;
  if (DIFF) {
    float* X = (float*)smem;
    const int qs = wave & 1;
    if (m == 1) {
#pragma unroll
      for (int d = 0; d < DB; ++d)
#pragma unroll
        for (int r = 0; r < 16; ++r) X[((qs * 64 + d * 16 + r) << 6) + lane] = O[d][r] * inv;
    }
    __syncthreads();
    if (m == 0) {
      const float lam = ((const float*)(ws + OFF_SCAL))[l];
      const float oml = 1.f - ((const float*)(ws + OFF_SCAL))[2 + l];
      float ss = 0.f;
#pragma unroll
      for (int d = 0; d < DB; ++d)
#pragma unroll
        for (int r = 0; r < 16; ++r) {
          float o = O[d][r] * inv - lam * X[((qs * 64 + d * 16 + r) << 6) + lane];
          O[d][r] = o; ss += o * o;
        }
      ss += __shfl_xor(ss, 32);
      const float rinv = rsqrtf(ss * (1.f / 128.f) + 1e-5f) * oml;
      const float* sg = p.in[I_SUBLN] + l * 128;
#pragma unroll
      for (int d = 0; d < DB; ++d)
#pragma unroll
        for (int g = 0; g < 4; ++g) {
          const int e = d * 32 + 8 * g + 4 * hf;
          float4 gg = *(const float4*)(sg + e);
          uint2 v = make_uint2(pack2(O[d][4 * g] * rinv * gg.x, O[d][4 * g + 1] * rinv * gg.y),
                               pack2(O[d][4 * g + 2] * rinv * gg.z, O[d][4 * g + 3] * rinv * gg.w));
          *(uint2*)(cc + h * 128 + e) = v;
        }
    }
    __syncthreads();
  } else {
#pragma unroll
    for (int d = 0; d < DB; ++d)
#pragma unroll
      for (int g = 0; g < 4; ++g) {
        const int e = d * 32 + 8 * g + 4 * hf;
        uint2 v = make_uint2(pack2(O[d][4 * g] * inv, O[d][4 * g + 1] * inv), pack2(O[d][4 * g + 2] * inv, O[d][4 * g + 3] * inv));
        *(uint2*)(cc + 512 + h * 64 + e) = v;
      }
  }
}

DI void phase_mixers(const Params& p, int l, char* smem, unsigned xcc) {
  __shared__ int4 s_item4;
  int& s_item = s_item4.x;
  int* ctrs = (int*)(p.ws + OFF_SCAL + 64) + l * 8;
  const int nqA = (l == 0) ? 68 : 64, nqB = (l == 0) ? 34 : 32;
  const int total = 16 + 2 * nqA + 2 * nqB;
  for (int dx = 0; dx < 8; ++dx) {
    const int q = (xcc + dx) & 7;
    while (true) {
      __syncthreads();
      if (TIDX == 0) s_item = atomicAdd(ctrs + q, 1);
      __syncthreads();
      const int j = s_item;
      if (j >= total) break;
      if (j < 16) scan_item(p, l, (2 * q + (j >> 3)) * 8 + (j & 7), smem);
      else if (j < 16 + 2 * nqA) { const int jj = j - 16; attn_item<true>(p, l, (2 * q + jj / nqA) * nqA + jj % nqA, smem); }
      else { const int jj = j - 16 - 2 * nqA; attn_item<false>(p, l, (2 * q + jj / nqB) * nqB + jj % nqB, smem); }
    }
  }
}

DI void phase_rwkv_post(const Params& p, int l) {
  char* ws = p.ws;
  const int lane = TIDX & 63, wave = TIDX >> 6;
  const u16* RB = (const u16*)(ws + OFF_RKVK);
  const u16* KB2 = RB + (size_t)R * 256;
  const u16* VB2 = KB2 + (size_t)R * 256;
  const int c = lane * 4;
  const float4 ka = *(const float4*)(p.in[I_KA] + l * 256 + c);
  const float4 rk = *(const float4*)(p.in[I_RK] + l * 256 + c);
  const float4 gg = *(const float4*)(p.in[I_GNG] + l * 256 + c);
  const float4 gb = *(const float4*)(p.in[I_GNB] + l * 256 + c);
  for (int row = blockIdx.x * 4 + wave; row < R; row += gridDim.x * 4) {
    if (l == 1 && (row % TT) < CTX) continue;
    const size_t ro = (size_t)row * 256 + c;
    float4 y = *(const float4*)((const float*)(ws + OFF_YS) + ro);
    uint2 ru = *(const uint2*)(RB + ro), ku = *(const uint2*)(KB2 + ro), vu = *(const uint2*)(VB2 + ro);
    uint2 af = *(const uint2*)((const u16*)(ws + OFF_AD) + ro), ab = *(const uint2*)((const u16*)(ws + OFF_AD) + (size_t)R * 256 + ro);
    uint2 gu = *(const uint2*)((const u16*)(ws + OFF_GATE) + ro);
    float s1 = y.x + y.y + y.z + y.w;
    s1 = sum16(s1);
    const float mu = s1 * (1.f / 64.f);
    float d0 = y.x - mu, d1 = y.y - mu, d2 = y.z - mu, d3 = y.w - mu;
    float s2 = sum16(d0 * d0 + d1 * d1 + d2 * d2 + d3 * d3);
    const float rs = rsqrtf(s2 * (1.f / 64.f) + 64e-5f);
    float r0 = lo_bf(ru.x), r1 = hi_bf(ru.x), r2 = lo_bf(ru.y), r3 = hi_bf(ru.y);
    float k0 = lo_bf(ku.x), k1 = hi_bf(ku.x), k2 = lo_bf(ku.y), k3 = hi_bf(ku.y);
    float bsum = 0.f;
    {
      float a0 = lo_bf(af.x), a1 = hi_bf(af.x), a2 = lo_bf(af.y), a3 = hi_bf(af.y);
      bsum += r0 * k0 * (1.f + (a0 - 1.f) * ka.x) * rk.x + r1 * k1 * (1.f + (a1 - 1.f) * ka.y) * rk.y +
              r2 * k2 * (1.f + (a2 - 1.f) * ka.z) * rk.z + r3 * k3 * (1.f + (a3 - 1.f) * ka.w) * rk.w;
      a0 = lo_bf(ab.x); a1 = hi_bf(ab.x); a2 = lo_bf(ab.y); a3 = hi_bf(ab.y);
      bsum += r0 * k0 * (1.f + (a0 - 1.f) * ka.x) * rk.x + r1 * k1 * (1.f + (a1 - 1.f) * ka.y) * rk.y +
              r2 * k2 * (1.f + (a2 - 1.f) * ka.z) * rk.z + r3 * k3 * (1.f + (a3 - 1.f) * ka.w) * rk.w;
    }
    bsum = sum16(bsum);
    float o0 = (d0 * rs * gg.x + gb.x + bsum * lo_bf(vu.x)) * lo_bf(gu.x);
    float o1 = (d1 * rs * gg.y + gb.y + bsum * hi_bf(vu.x)) * hi_bf(gu.x);
    float o2 = (d2 * rs * gg.z + gb.z + bsum * lo_bf(vu.y)) * lo_bf(gu.y);
    float o3 = (d3 * rs * gg.w + gb.w + bsum * hi_bf(vu.y)) * hi_bf(gu.y);
    *(uint2*)((u16*)(ws + OFF_HB) + (size_t)row * 1024 + 768 + c) = make_uint2(pack2(o0, o1), pack2(o2, o3));
  }
}

DI void phase_gemm_raw(const Params& p, int l, const u16* A, int lda, const u16* Wt, int K, float* out, char* smem) {
  XCD_TILE_LOOP(128, 8, 8) {
    XCD_TILE_DECODE(8, 8, ma, nt)
    const int mt = (ma >> 5) * 34 + 2 + (ma & 31);
    const int row0 = mt * 128;
    gemm_tile(A, lda, row0, 0, R, Wt + (size_t)nt * 128 * K, K, K, smem);
    store_bf16((const float*)smem, 0, 128, (u16*)out, 1024, row0, nt * 128);
  }
  if (l == 0) {
    const int Kq = K >> 2;
    for (int it = blockIdx.x; it < 256; it += gridDim.x) {
      const int kq = it & 3, nt = (it >> 2) & 7, cm = it >> 5;
      const int row0 = (cm >> 1) * TT + (cm & 1) * 128;
      gemm_tile(A + kq * Kq, lda, row0, 0, R, Wt + (size_t)nt * 128 * K + kq * Kq, K, Kq, smem);
      store_bf16((const float*)smem, 0, 128, (u16*)(p.ws + OFF_PART) + (size_t)kq * 1024 * 1024, 1024, cm * 128, nt * 128);
    }
  }
}

DI void phase_ffn_up(const Params& p, int l, char* smem) {
  char* ws = p.ws;
  const float* cw = p.in[I_CONVW] + (size_t)l * 3 * 5632;
  const float* cb = p.in[I_CONVB] + (size_t)l * 5632;
  u16* act = (u16*)(ws + OFF_ACT);
  u16* sb = (u16*)(ws + OFF_PART);
  const int mtn = (l == 0) ? MT : 128;
  XCD_TILE_LOOP(mtn, 44, 11) {
    XCD_TILE_DECODE(44, 11, ma, nt)
    const int mt = (l == 0) ? ma : (ma >> 5) * 34 + 2 + (ma & 31);
    const int row0 = mt * 128;
    gemm_tile((const u16*)(ws + OFF_HB), 1024, row0, 0, R, (const u16*)(ws + OFF_WT_UP) + (size_t)nt * 128 * 1024, 1024, 1024, smem);
    const float* T = (const float*)smem;
    const int tid_ = TIDX;
    {
      const int slot = tid_ >> 6, j2 = (tid_ & 63) * 2, ri = slot < 2 ? slot : 124 + slot;
      *(unsigned*)(sb + ((size_t)mt * 4 + slot) * 5632 + nt * 128 + j2) = pack2(T[ri * TS + j2], T[ri * TS + j2 + 1]);
    }
    const int j = 2 * (tid_ & 31), i0 = 1 + (tid_ >> 5) * 16;
    const int cg0 = nt * 64 + j;
    float wg[2][3], wv[2][3], bg[2], bv[2];
#pragma unroll
    for (int q = 0; q < 2; ++q) {
#pragma unroll
      for (int k = 0; k < 3; ++k) { wg[q][k] = cw[k * 5632 + cg0 + q]; wv[q][k] = cw[k * 5632 + DFF + cg0 + q]; }
      bg[q] = cb[cg0 + q]; bv[q] = cb[DFF + cg0 + q];
    }
    float gp[2], gc[2], vp[2], vc[2];
#pragma unroll
    for (int q = 0; q < 2; ++q) {
      gp[q] = T[(i0 - 1) * TS + j + q]; vp[q] = T[(i0 - 1) * TS + 64 + j + q];
      gc[q] = T[i0 * TS + j + q];       vc[q] = T[i0 * TS + 64 + j + q];
    }
#pragma unroll 4
    for (int ii = 0; ii < 16; ++ii) {
      const int i = i0 + ii;
      if (i > 126) break;
      float gn[2], vn[2], res[2];
#pragma unroll
      for (int q = 0; q < 2; ++q) { gn[q] = T[(i + 1) * TS + j + q]; vn[q] = T[(i + 1) * TS + 64 + j + q]; }
#pragma unroll
      for (int q = 0; q < 2; ++q) {
        float g = wg[q][0] * gp[q] + wg[q][1] * gc[q] + wg[q][2] * gn[q] + bg[q];
        float v = wv[q][0] * vp[q] + wv[q][1] * vc[q] + wv[q][2] * vn[q] + bv[q];
        res[q] = g * __builtin_amdgcn_rcpf(1.f + __expf(-g)) * v;
        gp[q] = gc[q]; gc[q] = gn[q]; vp[q] = vc[q]; vc[q] = vn[q];
      }
      *(unsigned*)(act + (size_t)(row0 + i) * DFF + cg0) = pack2(res[0], res[1]);
    }
  }
}
DI void phase_ffn_fix(const Params& p, int l) {
  char* ws = p.ws;
  const float* cw = p.in[I_CONVW] + (size_t)l * 3 * 5632;
  const float* cb = p.in[I_CONVB] + (size_t)l * 5632;
  u16* act = (u16*)(ws + OFF_ACT);
  const u16* sb = (const u16*)(ws + OFF_PART);
  const int nit = ((l == 0) ? MT : 128) * 2;
  for (int it = blockIdx.x; it < nit; it += gridDim.x) {
    const int ma = it >> 1, last = it & 1;
    const int mt = (l == 0) ? ma : (ma >> 5) * 34 + 2 + (ma & 31);
    const int ti = mt % 34;
    const bool seg_first = (ti == 0 || ti == 2), seg_last = (ti == 1 || ti == 33);
    const u16* cur = sb + ((size_t)mt * 4 + (last ? 3 : 0)) * 5632;
    const u16* prv = last ? sb + ((size_t)mt * 4 + 2) * 5632 : (seg_first ? nullptr : sb + ((size_t)(mt - 1) * 4 + 3) * 5632);
    const u16* nxt = last ? (seg_last ? nullptr : sb + ((size_t)(mt + 1) * 4 + 0) * 5632) : sb + ((size_t)mt * 4 + 1) * 5632;
    const int row = mt * 128 + (last ? 127 : 0);
    for (int c = TIDX; c < DFF; c += 256) {
      const int cg = (c >> 6) * 128 + (c & 63), cv = cg + 64;
      const float g = cw[c] * (prv ? bf2f(prv[cg]) : 0.f) + cw[5632 + c] * bf2f(cur[cg]) + cw[2 * 5632 + c] * (nxt ? bf2f(nxt[cg]) : 0.f) + cb[c];
      const float v = cw[DFF + c] * (prv ? bf2f(prv[cv]) : 0.f) + cw[5632 + DFF + c] * bf2f(cur[cv]) + cw[2 * 5632 + DFF + c] * (nxt ? bf2f(nxt[cv]) : 0.f) + cb[DFF + c];
      act[(size_t)row * DFF + c] = f2bf(g * __builtin_amdgcn_rcpf(1.f + __expf(-g)) * v);
    }
  }
}

#define XB_TMO      128
#define XB_XCNT(j)  (256  + 64 * (j))
#define XB_XSUB(j)  (1280 + 64 * (j))
#define XB_XGEN(j)  (2304 + 64 * (j))
#define XB_TOP      3328
#define XB_TOPGEN   3392
#define XCD_BAR_WORDS 3456
#define XB_SPIN_CAP (1u << 24)
#define LAS __attribute__((address_space(3)))
DI unsigned xb_ld(unsigned* p) { return __hip_atomic_load(p, __ATOMIC_RELAXED, __HIP_MEMORY_SCOPE_AGENT); }
DI unsigned xb_add(unsigned* p, unsigned v) { return __hip_atomic_fetch_add(p, v, __ATOMIC_RELAXED, __HIP_MEMORY_SCOPE_AGENT); }
DI unsigned xb_xcc_id() { return (unsigned)__builtin_amdgcn_s_getreg((3 << 11) | 20) & 0xFu; }
#define XB_SPIN(cond, bar) do { unsigned _sp = 0; while (cond) { __builtin_amdgcn_s_sleep(1); \
    if ((++_sp & 255u) == 0u) { if (xb_ld(&(bar)[XB_TMO])) break; if (_sp > XB_SPIN_CAP) { atomicAdd(&(bar)[XB_TMO], 1u); break; } } } } while (0)
struct XcdBarrier { unsigned* bar; unsigned x; volatile LAS unsigned* st; };
DI XcdBarrier xcd_barrier_post(unsigned* bar, volatile LAS unsigned* st) {
  XcdBarrier b; b.bar = bar; b.x = xb_xcc_id(); b.st = st;
  if (threadIdx.x == 0) (void)xb_add(&bar[XB_XCNT(b.x)], 1u);
  return b;
}
DI void xcd_barrier_complete(unsigned* bar, unsigned x, unsigned& nloc, unsigned& nx) {
  const unsigned G = gridDim.x * gridDim.y * gridDim.z;
  unsigned sum, cnt, mine, sp = 0u;
  for (;;) {
    sum = 0u; cnt = 0u; mine = 0u;
#pragma unroll
    for (unsigned j = 0; j < 16; ++j) { const unsigned c = xb_ld(&bar[XB_XCNT(j)]); sum += c; cnt += (c > 0u) ? 1u : 0u; mine = (j == x) ? c : mine; }
    if (sum == G) break;
    __builtin_amdgcn_s_sleep(1);
    if ((++sp & 255u) == 0u) { if (xb_ld(&bar[XB_TMO])) break; if (sp > XB_SPIN_CAP) { atomicAdd(&bar[XB_TMO], 1u); break; } }
  }
  nloc = mine > 0u ? mine : 1u; nx = cnt > 0u ? cnt : 1u;
}
DI void xcd_barrier(const XcdBarrier& b) {
  asm volatile("s_waitcnt vmcnt(0)" ::: "memory");
  __syncthreads();
  if (threadIdx.x == 0) {
    unsigned* bar = b.bar;
    __builtin_amdgcn_s_waitcnt(0);
    unsigned nloc = b.st[0], nx = b.st[1];
    if (nloc == 0u) { xcd_barrier_complete(bar, b.x, nloc, nx); b.st[0] = nloc; b.st[1] = nx; }
    const unsigned old = xb_add(&bar[XB_XSUB(b.x)], 1u);
    const unsigned gen = old / nloc;
    if (old + 1u == (gen + 1u) * nloc) {
      __builtin_amdgcn_fence(__ATOMIC_RELEASE, "agent");
      asm volatile("s_waitcnt vmcnt(0)" ::: "memory");
      const unsigned og = xb_add(&bar[XB_TOP], 1u);
      const unsigned tg = og / nx;
      if (og + 1u == (tg + 1u) * nx) xb_add(&bar[XB_TOPGEN], 1u);
      else XB_SPIN(xb_ld(&bar[XB_TOPGEN]) == tg, bar);
      __builtin_amdgcn_fence(__ATOMIC_ACQUIRE, "agent");
      xb_add(&bar[XB_XGEN(b.x)], 1u);
      asm volatile("s_waitcnt vmcnt(0)" ::: "memory");
    } else {
      XB_SPIN(xb_ld(&bar[XB_XGEN(b.x)]) == gen, bar);
      __builtin_amdgcn_fence(__ATOMIC_ACQUIRE, "agent");
      asm volatile("s_waitcnt vmcnt(0)" ::: "memory");
    }
  }
  __syncthreads();
}

__global__ void __launch_bounds__(256, 2) fwd_megakernel(Params p) {
  extern __shared__ __attribute__((aligned(16))) char smem[];
  cg::grid_group grid = cg::this_grid();
  char* ws = p.ws;
  __shared__ uint4 xb_words;
  if (threadIdx.x == 0) xb_words = make_uint4(0u, 0u, 0u, 0u);
  __syncthreads();
  XcdBarrier xb = xcd_barrier_post((unsigned*)(ws + OFF_BAR), (volatile LAS unsigned*)&xb_words);
  if (blockIdx.x == 0) misc_setup(p);
  for (int it = blockIdx.x; it < 192 + NCONV_MIX; it += gridDim.x) {
    if (it < 192) mod_item(p, it, smem); else convert_mix_item(p, 0, it - 192, smem);
  }
  if (p.ws == nullptr) grid.sync(); else xcd_barrier(xb);
  for (int l = 0; l < 2; ++l) {
    if (l == 0) norm_phase(p, 0, 0, 2, 0, true, false);
    else {
      norm_phase(p, 2, 0, 2, 1, false, false);
      for (int it = blockIdx.x; it < NCONV_MIX; it += gridDim.x) convert_mix_item(p, 1, it, smem);
    }
    xcd_barrier(xb);
    phase_gemm_in(p, smem);
    xcd_barrier(xb);
    phase_prep(p, l);
    xcd_barrier(xb);
    phase_small_gemms(p, l, smem);
    xcd_barrier(xb);
    phase_mixers(p, l, smem, xb.x);
    xcd_barrier(xb);
    phase_rwkv_post(p, l);
    xcd_barrier(xb);
    phase_gemm_raw(p, l, (const u16*)(ws + OFF_HB), 1024, (const u16*)(ws + OFF_WT_OUT), 1024, (float*)(ws + OFF_RAW), smem);
    xcd_barrier(xb);
    norm_phase(p, 1, l, 1, l, l == 0, l == 1);
    for (int it = blockIdx.x; it < NCONV_FFN; it += gridDim.x) convert_ffn_item(p, l, it, smem);
    xcd_barrier(xb);
    phase_ffn_up(p, l, smem);
    xcd_barrier(xb);
    phase_ffn_fix(p, l);
    xcd_barrier(xb);
    phase_gemm_raw(p, l, (const u16*)(ws + OFF_ACT), DFF, (const u16*)(ws + OFF_WT_DOWN), DFF, (float*)(ws + OFF_RAW2), smem);
    xcd_barrier(xb);
  }
  norm_phase(p, 2, 1, 0, 0, false, true);
}

extern "C" void kernel_launch(void* const* d_in, const int* in_sizes, int n_in, void* d_out, int out_size,
                              void* d_ws, size_t ws_size, hipStream_t stream) {
  static int grid_blocks = 0;
  if (!grid_blocks) {
    int dev = 0, cus = 0, per_cu = 0;
    hipGetDevice(&dev);
    hipDeviceGetAttribute(&cus, hipDeviceAttributeMultiprocessorCount, dev);
    hipFuncSetAttribute((const void*)fwd_megakernel, hipFuncAttributeMaxDynamicSharedMemorySize, SMEM_BYTES);
    hipOccupancyMaxActiveBlocksPerMultiprocessor(&per_cu, fwd_megakernel, 256, SMEM_BYTES);
    if (per_cu > 2) per_cu = 2;
    if (per_cu < 1) per_cu = 1;
    grid_blocks = cus * per_cu;
  }
  hipMemsetAsync((char*)d_ws + OFF_BAR, 0, XCD_BAR_WORDS * 4, stream);
  Params p{};
  for (int i = 0; i < N_INPUTS; ++i) p.in[i] = (const float*)d_in[i];
  p.out = (float*)d_out;
  p.ws = (char*)d_ws;
  void* args[] = {&p};
  hipError_t e = hipLaunchCooperativeKernel((const void*)fwd_megakernel, dim3(grid_blocks), dim3(256), args, SMEM_BYTES, stream);
  if (e != hipSuccess) fprintf(stderr, "cooperative launch failed: %s (grid %d)\n", hipGetErrorString(e), grid_blocks);
}
```

```cpp
#include <hip/hip_runtime.h>
#include <hip/hip_cooperative_groups.h>
#include <stdint.h>
#include <stdio.h>
namespace cg = cooperative_groups;

#define DI __device__ __forceinline__
typedef unsigned short u16;
typedef __attribute__((ext_vector_type(8))) short bf16x8;
typedef __attribute__((ext_vector_type(4))) short s16x4;
typedef __attribute__((ext_vector_type(16))) float f32x16;
typedef __bf16 bf2_t __attribute__((ext_vector_type(2)));
typedef float f2_t __attribute__((ext_vector_type(2)));
typedef unsigned u32x4 __attribute__((ext_vector_type(4)));
typedef unsigned u32x2 __attribute__((ext_vector_type(2)));

constexpr int D = 1024, NB = 4, SEQ = 4096, CTX = 256, TT = SEQ + CTX, R = NB * TT, MT = R / 128;
constexpr int DFF = 2816;
constexpr float LOG2E = 1.4426950408889634f;

enum { I_X = 0, I_C, I_CTX, I_CCTX, I_ADAW, I_ADAB, I_MIXPRE, I_MIXPOST, I_FFNPRE, I_FFNPOST, I_WIN, I_WOUT,
       I_LQ1, I_LK1, I_LQ2, I_LK2, I_SUBLN, I_BQG, I_BWQ, I_BKVG, I_BWKV, I_MUP, I_MUN, I_W0, I_W2, I_A0, I_A2,
       I_G2, I_KK, I_KA, I_RK, I_GNG, I_GNB, I_WUP, I_CONVW, I_CONVB, I_WDOWN, N_INPUTS };

struct Params { const float* in[N_INPUTS]; float* out; char* ws; };

constexpr size_t al(size_t x) { return (x + 255) & ~size_t(255); }
constexpr size_t OFF_MOD = 0;
constexpr size_t OFF_SCAL = OFF_MOD + al(2 * 5 * 6144 * 4);
constexpr size_t OFF_BAR = OFF_SCAL + 1024;
constexpr size_t OFF_ROPE = OFF_BAR + 16384;
constexpr size_t OFF_KR = OFF_ROPE + al(3072 * 4);
constexpr size_t OFF_XC = OFF_KR + al((size_t)R * 32 * 2);
constexpr size_t OFF_WMIX = OFF_XC + al((size_t)1024 * 1024 * 4);
constexpr size_t OFF_WT_IN = OFF_WMIX;
constexpr size_t OFF_WT_OUT = OFF_WT_IN + (size_t)3072 * 1024 * 2;
constexpr size_t OFF_WT_Q = OFF_WT_OUT + (size_t)1024 * 1024 * 2;
constexpr size_t OFF_WT_KV = OFF_WT_Q + (size_t)384 * 192 * 2;
constexpr size_t OFF_WT_W2 = OFF_WT_KV + (size_t)512 * 128 * 2;
constexpr size_t OFF_WT_A2 = OFF_WT_W2 + (size_t)2 * 256 * 64 * 2;
constexpr size_t OFF_WT_G2 = OFF_WT_A2 + (size_t)2 * 256 * 64 * 2;
constexpr size_t OFF_HB = al(OFF_WT_G2 + (size_t)256 * 128 * 2);
constexpr size_t OFF_BRAW = OFF_HB;
constexpr size_t OFF_LORA = OFF_HB + (size_t)R * 384 * 2;
constexpr size_t OFF_QA = OFF_HB + (size_t)R * 1024 * 2;
constexpr size_t OFF_KA = OFF_QA + (size_t)R * 512 * 2;
constexpr size_t OFF_VTA = OFF_KA + (size_t)R * 512 * 2;
constexpr size_t OFF_CRAW = OFF_VTA + (size_t)R * 512 * 2;
constexpr size_t OFF_DECAY = OFF_CRAW;
constexpr size_t OFF_QB = OFF_CRAW + (size_t)R * 1152 * 2;
constexpr size_t OFF_KBN = OFF_QB + (size_t)R * 384 * 2;
constexpr size_t OFF_VTB = OFF_KBN + (size_t)R * 256 * 2;
constexpr size_t OFF_AD = OFF_VTB + (size_t)R * 256 * 2;
constexpr size_t OFF_GATE = OFF_AD + (size_t)2 * R * 256 * 2;
constexpr size_t OFF_YS = OFF_GATE + (size_t)R * 256 * 2;
constexpr size_t OFF_RKVK = OFF_YS + (size_t)R * 256 * 4;
constexpr size_t OFF_H1 = OFF_RKVK;
constexpr size_t OFF_WT_UP = OFF_RKVK;
constexpr size_t OFF_WT_DOWN = OFF_WT_UP + (size_t)5632 * 1024 * 2;
constexpr size_t OFF_PART = OFF_RKVK + (size_t)R * 1024 * 2;
constexpr size_t OFF_END = OFF_PART + (size_t)4 * 1024 * 1024 * 2;
constexpr size_t OFF_RAW = OFF_QA;
constexpr size_t OFF_ACT = OFF_QA;
constexpr size_t OFF_RAW2 = OFF_ACT + (size_t)R * DFF * 2;
static_assert(OFF_RAW2 + (size_t)R * 1024 * 4 <= OFF_RKVK, "raw2 overlap");
static_assert(OFF_RAW + (size_t)R * 1024 * 4 <= OFF_QB, "raw overlap");
static_assert(OFF_WT_DOWN + (size_t)1024 * DFF * 2 <= OFF_PART, "ffn weights");
static_assert(OFF_END <= (size_t)256 * 1024 * 1024, "workspace");
static_assert((size_t)2 * R * 256 * 4 <= (size_t)R * 1152 * 2, "decay fits craw");

constexpr int SMEM_BYTES = 73728;
constexpr int TS = 133;

DI int opaque_tid() { int t = threadIdx.x; asm volatile("" : "+v"(t)); return t; }
#define TIDX opaque_tid()
DI float bf2f(u16 v) { return __uint_as_float(((unsigned)v) << 16); }
DI unsigned pack2(float a, float b) { f2_t v = {a, b}; bf2_t r = __builtin_convertvector(v, bf2_t); return __builtin_bit_cast(unsigned, r); }
DI u16 f2bf(float a) { return (u16)(pack2(a, 0.f) & 0xffffu); }
DI float lo_bf(unsigned u) { return __uint_as_float(u << 16); }
DI float hi_bf(unsigned u) { return __uint_as_float(u & 0xffff0000u); }
DI float wave_sum(float x) {
#pragma unroll
  for (int o = 32; o > 0; o >>= 1) x += __shfl_xor(x, o);
  return x;
}
template <int CTRL> DI float dpp_add(float x) {
  int v = __builtin_amdgcn_update_dpp(0, __float_as_int(x), CTRL, 0xF, 0xF, true);
  return x + __int_as_float(v);
}
DI float sum16(float x) {
  x = dpp_add<0xB1>(x); x = dpp_add<0x4E>(x); x = dpp_add<0x141>(x); x = dpp_add<0x140>(x);
  return x;
}
DI int crow(int reg, int hf) { return (reg & 3) + 8 * (reg >> 2) + 4 * hf; }
DI float sigmoidf_(float x) { return __builtin_amdgcn_rcpf(1.f + __expf(-x)); }
#define MFMA32(a, b, c) __builtin_amdgcn_mfma_f32_32x32x16_bf16((a), (b), (c), 0, 0, 0)

DI void gemm_tile(const u16* __restrict__ A, int lda, int arow0, int alo, int ahi,
                  const u16* __restrict__ Bt, int ldb, int K, char* smem) {
  const int tid = TIDX, lane = tid & 63, wave = tid >> 6, wm = wave >> 1, wn = wave & 1, l32 = lane & 31, hf = lane >> 5;
  const int srow = tid >> 3, sch = tid & 7;
  f32x16 acc[2][2];
#pragma unroll
  for (int i = 0; i < 2; ++i)
#pragma unroll
    for (int j = 0; j < 2; ++j)
#pragma unroll
      for (int r = 0; r < 16; ++r) acc[i][j][r] = 0.f;
  u32x4 ra0[4], rb0[4], ra1[4], rb1[4];
  const u32x4 z4 = {0u, 0u, 0u, 0u};
  const u16* ap[4]; const u16* bp[4]; bool av[4];
#pragma unroll
  for (int i = 0; i < 4; ++i) {
    int row = srow + 32 * i, ar = arow0 + row;
    int arc = min(max(ar, alo), ahi - 1);
    av[i] = (ar == arc);
    ap[i] = A + (size_t)arc * lda + sch * 8;
    bp[i] = Bt + (size_t)row * ldb + sch * 8;
  }
  const int nk = K >> 6;
#define G_LOAD(RA, RB, KT) \
  _Pragma("unroll") for (int i = 0; i < 4; ++i) { u32x4 va = *(const u32x4*)(ap[i] + (KT) * 64); if (!av[i]) va = z4; RA[i] = va; RB[i] = *(const u32x4*)(bp[i] + (KT) * 64); }
#define G_STORE(RA, RB, BUF) \
  _Pragma("unroll") for (int i = 0; i < 4; ++i) { int row = srow + 32 * i; \
    *(u32x4*)(smem + (BUF) * 36864 + row * 144 + sch * 16) = RA[i]; *(u32x4*)(smem + (BUF) * 36864 + 18432 + row * 144 + sch * 16) = RB[i]; }
#define G_COMPUTE(BUF) { \
    const char* sa = smem + (BUF) * 36864; const char* sb = sa + 18432; \
    _Pragma("unroll") for (int ks = 0; ks < 4; ++ks) { \
      const int ko = (ks * 16 + hf * 8) * 2; \
      bf16x8 a0 = *(const bf16x8*)(sa + (wm * 64 + l32) * 144 + ko); \
      bf16x8 a1 = *(const bf16x8*)(sa + (wm * 64 + 32 + l32) * 144 + ko); \
      bf16x8 b0 = *(const bf16x8*)(sb + (wn * 64 + l32) * 144 + ko); \
      bf16x8 b1 = *(const bf16x8*)(sb + (wn * 64 + 32 + l32) * 144 + ko); \
      acc[0][0] = MFMA32(a0, b0, acc[0][0]); acc[0][1] = MFMA32(a0, b1, acc[0][1]); \
      acc[1][0] = MFMA32(a1, b0, acc[1][0]); acc[1][1] = MFMA32(a1, b1, acc[1][1]); } }
  __syncthreads();
  G_LOAD(ra0, rb0, 0)
  if (nk > 1) { G_LOAD(ra1, rb1, 1) }
  G_STORE(ra0, rb0, 0)
  __syncthreads();
  for (int kt = 0; kt < nk; kt += 2) {
    if (kt + 2 < nk) { G_LOAD(ra0, rb0, kt + 2) }
    G_COMPUTE(0)
    if (kt + 1 < nk) { G_STORE(ra1, rb1, 1) }
    __syncthreads();
    if (kt + 1 < nk) {
      if (kt + 3 < nk) { G_LOAD(ra1, rb1, kt + 3) }
      G_COMPUTE(1)
      if (kt + 2 < nk) { G_STORE(ra0, rb0, 0) }
      __syncthreads();
    }
  }
#undef G_LOAD
#undef G_STORE
#undef G_COMPUTE
  float* T = (float*)smem;
#pragma unroll
  for (int mi = 0; mi < 2; ++mi)
#pragma unroll
    for (int ni = 0; ni < 2; ++ni)
#pragma unroll
      for (int r = 0; r < 16; ++r)
        T[(wm * 64 + mi * 32 + crow(r, hf)) * TS + wn * 64 + ni * 32 + l32] = acc[mi][ni][r];
  __syncthreads();
}

DI void store_bf16(const float* T, int jc0, int ncols, u16* out, size_t ld, int row0, int col0) {
  const int np = ncols >> 1, sh = (ncols == 128) ? 6 : 5;
  for (int e = TIDX; e < 128 * np; e += 256) {
    int i = e >> sh, j = 2 * (e & (np - 1));
    *(unsigned*)(out + (size_t)(row0 + i) * ld + col0 + j) = pack2(T[i * TS + jc0 + j], T[i * TS + jc0 + j + 1]);
  }
}
DI void store_bf16_T(const float* T, int jc0, int ncols, u16* out, int s0) {
  for (int e = TIDX; e < ncols * 64; e += 256) {
    int c = e >> 6, i2 = e & 63;
    *(unsigned*)(out + (size_t)c * TT + s0 + 2 * i2) = pack2(T[(2 * i2) * TS + jc0 + c], T[(2 * i2 + 1) * TS + jc0 + c]);
  }
}

DI int srccol(int mode, int np) {
  if (mode == 1) return np < 1888 ? np : (np < 1920 ? -1 : np - 32);
  if (mode == 2) { if (np < 256) return (np >> 6) * 96 + (np & 63); int j = np - 256; return (j >> 5) * 96 + 64 + (j & 31); }
  if (mode == 3) { int t = np >> 7, j = np & 127; return j < 64 ? t * 64 + j : DFF + t * 64 + j - 64; }
  return np;
}
DI void convert_tile(const float* __restrict__ src, int ldw, int k0, int n0, u16* __restrict__ dst, int ldd, int mode, char* smem) {
  float* T = (float*)smem;
  const int tid = TIDX;
  __syncthreads();
  {
    const int r0 = tid >> 4, c4 = (tid & 15) * 4;
    const int sc = srccol(mode, n0 + c4);
    float4 v[4];
#pragma unroll
    for (int ps = 0; ps < 4; ++ps)
      v[ps] = sc < 0 ? make_float4(0.f, 0.f, 0.f, 0.f) : *(const float4*)(src + (size_t)(k0 + ps * 16 + r0) * ldw + sc);
#pragma unroll
    for (int ps = 0; ps < 4; ++ps) {
      float* t = T + (ps * 16 + r0) * 65 + c4;
      t[0] = v[ps].x; t[1] = v[ps].y; t[2] = v[ps].z; t[3] = v[ps].w;
    }
  }
  __syncthreads();
#pragma unroll
  for (int it = 0; it < 2; ++it) {
    int nn = it * 32 + (tid >> 3), kc = tid & 7;
    uint4 v;
    v.x = pack2(T[(kc * 8 + 0) * 65 + nn], T[(kc * 8 + 1) * 65 + nn]);
    v.y = pack2(T[(kc * 8 + 2) * 65 + nn], T[(kc * 8 + 3) * 65 + nn]);
    v.z = pack2(T[(kc * 8 + 4) * 65 + nn], T[(kc * 8 + 5) * 65 + nn]);
    v.w = pack2(T[(kc * 8 + 6) * 65 + nn], T[(kc * 8 + 7) * 65 + nn]);
    *(uint4*)(dst + (size_t)(n0 + nn) * ldd + k0 + kc * 8) = v;
  }
}
constexpr int NCONV_MIX = 768 + 256 + 18 + 16 + 8 + 8 + 8;
DI void convert_mix_item(const Params& p, int l, int it, char* smem) {
  char* ws = p.ws;
  if (it < 768) { convert_tile(p.in[I_WIN] + (size_t)l * 1024 * 3040, 3040, (it / 48) * 64, (it % 48) * 64, (u16*)(ws + OFF_WT_IN), 1024, 1, smem); return; }
  it -= 768;
  if (it < 256) { convert_tile(p.in[I_WOUT] + (size_t)l * 1024 * 1024, 1024, (it / 16) * 64, (it % 16) * 64, (u16*)(ws + OFF_WT_OUT), 1024, 0, smem); return; }
  it -= 256;
  if (it < 18) { convert_tile(p.in[I_BWQ] + (size_t)l * 192 * 384, 384, (it / 6) * 64, (it % 6) * 64, (u16*)(ws + OFF_WT_Q), 192, 2, smem); return; }
  it -= 18;
  if (it < 16) { convert_tile(p.in[I_BWKV] + (size_t)l * 128 * 512, 512, (it / 8) * 64, (it % 8) * 64, (u16*)(ws + OFF_WT_KV), 128, 0, smem); return; }
  it -= 16;
  if (it < 8) { int d = it >> 2; convert_tile(p.in[I_W2] + (size_t)(l * 2 + d) * 64 * 256, 256, 0, (it & 3) * 64, (u16*)(ws + OFF_WT_W2) + d * 256 * 64, 64, 0, smem); return; }
  it -= 8;
  if (it < 8) { int d = it >> 2; convert_tile(p.in[I_A2] + (size_t)(l * 2 + d) * 64 * 256, 256, 0, (it & 3) * 64, (u16*)(ws + OFF_WT_A2) + d * 256 * 64, 64, 0, smem); return; }
  it -= 8;
  convert_tile(p.in[I_G2] + (size_t)l * 128 * 256, 256, (it / 4) * 64, (it % 4) * 64, (u16*)(ws + OFF_WT_G2), 128, 0, smem);
}
constexpr int NCONV_FFN = 16 * 88 + 44 * 16;
DI void convert_ffn_item(const Params& p, int l, int it, char* smem) {
  char* ws = p.ws;
  if (it < 1408) { convert_tile(p.in[I_WUP] + (size_t)l * 1024 * 5632, 5632, (it / 88) * 64, (it % 88) * 64, (u16*)(ws + OFF_WT_UP), 1024, 3, smem); return; }
  it -= 1408;
  convert_tile(p.in[I_WDOWN] + (size_t)l * DFF * 1024, 1024, (it / 16) * 64, (it % 16) * 64, (u16*)(ws + OFF_WT_DOWN), DFF, 0, smem);
}

DI void mod_item(const Params& p, int item, char* smem) {
  const int tid = TIDX, lane = tid & 63, kg = tid >> 6;
  const int l = item / 96, cb = item % 96;
  float* act = (float*)smem;
  float* red = act + 5 * 1024;
  __syncthreads();
  for (int i = tid; i < 5120; i += 256) {
    int bb = i >> 10, k = i & 1023;
    float v = bb < 4 ? p.in[I_C][bb * 1024 + k] : p.in[I_CCTX][k];
    act[i] = v / (1.f + __expf(-v));
  }
  __syncthreads();
  float a0 = 0, a1 = 0, a2 = 0, a3 = 0, a4 = 0;
  const float* W = p.in[I_ADAW] + ((size_t)l * 1024 + kg * 256) * 6144 + cb * 64 + lane;
  const float* ac = act + kg * 256;
#pragma unroll 32
  for (int k = 0; k < 256; ++k) {
    float w = W[(size_t)k * 6144];
    a0 += ac[k] * w; a1 += ac[1024 + k] * w; a2 += ac[2048 + k] * w; a3 += ac[3072 + k] * w; a4 += ac[4096 + k] * w;
  }
  red[(kg * 5 + 0) * 64 + lane] = a0; red[(kg * 5 + 1) * 64 + lane] = a1; red[(kg * 5 + 2) * 64 + lane] = a2;
  red[(kg * 5 + 3) * 64 + lane] = a3; red[(kg * 5 + 4) * 64 + lane] = a4;
  __syncthreads();
  float* mod = (float*)(p.ws + OFF_MOD);
  for (int idx = tid; idx < 320; idx += 256) {
    int bb = idx >> 6, c = idx & 63;
    float s = red[(0 * 5 + bb) * 64 + c] + red[(1 * 5 + bb) * 64 + c] + red[(2 * 5 + bb) * 64 + c] + red[(3 * 5 + bb) * 64 + c];
    mod[(size_t)(l * 5 + bb) * 6144 + cb * 64 + c] = s + p.in[I_ADAB][l * 6144 + cb * 64 + c];
  }
}
DI void misc_setup(const Params& p) {
  const int tid = TIDX;
  float* rope = (float*)(p.ws + OFF_ROPE);
  for (int i = tid; i < 1024; i += 256) {
    int pos = i >> 4, f = i & 15;
    float inv = exp2f(-(float)f * (13.287712379549449f / 16.f));
    float a = (float)pos * inv;
    rope[i] = cosf(a); rope[1024 + i] = sinf(a);
  }
  for (int i = tid; i < 512; i += 256) {
    int pos = i >> 3, f = i & 7;
    float inv = exp2f(-(float)f * (13.287712379549449f / 8.f));
    float a = (float)pos * inv;
    rope[2048 + i] = cosf(a); rope[2560 + i] = sinf(a);
  }
  if (tid < 16) ((int*)(p.ws + OFF_SCAL + 64))[tid] = 0;
  if (tid < 2) {
    int l = tid;
    float s1 = 0, s2 = 0;
    for (int i = 0; i < 64; ++i) {
      s1 += p.in[I_LQ1][l * 64 + i] * p.in[I_LK1][l * 64 + i];
      s2 += p.in[I_LQ2][l * 64 + i] * p.in[I_LK2][l * 64 + i];
    }
    float lam_init = 0.8f - 0.6f * expf(-0.3f * (float)l);
    ((float*)(p.ws + OFF_SCAL))[l] = expf(s1) - expf(s2) + lam_init;
    ((float*)(p.ws + OFF_SCAL))[2 + l] = lam_init;
  }
}

DI void norm_phase(const Params& p, int post, int lpost, int pre, int lpre, bool xin_input, bool skip_ctx) {
  const int lane = TIDX & 63, wave = TIDX >> 6;
  const float* mod = (const float*)(p.ws + OFF_MOD);
  for (int row = blockIdx.x * 4 + wave; row < R; row += gridDim.x * 4) {
    const int b = row / TT, s = row % TT;
    const bool isctx = s < CTX;
    if (isctx && skip_ctx) continue;
    const int bb = isctx ? 4 : b;
    const float* xin;
    float* xst = isctx ? (float*)(p.ws + OFF_XC) + (size_t)(b * CTX + s) * D : p.out + (size_t)(b * SEQ + s - CTX) * D;
    if (xin_input) xin = isctx ? p.in[I_CTX] + (size_t)(b * CTX + s) * D : p.in[I_X] + (size_t)(b * SEQ + s - CTX) * D;
    else xin = xst;
    float4 x[4];
#pragma unroll
    for (int i = 0; i < 4; ++i) x[i] = *(const float4*)(xin + (i * 64 + lane) * 4);
    if (post) {
      const u16* raw = (const u16*)(p.ws + (post == 1 ? OFF_RAW : OFF_RAW2)) + (size_t)row * D;
      const float* pg = p.in[post == 1 ? I_MIXPOST : I_FFNPOST] + lpost * D;
      const float* gt = mod + (size_t)(lpost * 5 + bb) * 6144 + (post == 1 ? 2048 : 5120);
      float4 o[4];
      float ss = 0.f;
#pragma unroll
      for (int i = 0; i < 4; ++i) {
        if (isctx) {
          const u16* pp = (const u16*)(p.ws + OFF_PART) + (size_t)(b * CTX + s) * D + (i * 64 + lane) * 4;
          o[i] = make_float4(0.f, 0.f, 0.f, 0.f);
#pragma unroll
          for (int q = 0; q < 4; ++q) {
            const uint2 ru = *(const uint2*)(pp + (size_t)q * 1024 * 1024);
            o[i].x += lo_bf(ru.x); o[i].y += hi_bf(ru.x); o[i].z += lo_bf(ru.y); o[i].w += hi_bf(ru.y);
          }
        } else {
          const uint2 ru = *(const uint2*)(raw + (i * 64 + lane) * 4);
          o[i] = make_float4(lo_bf(ru.x), hi_bf(ru.x), lo_bf(ru.y), hi_bf(ru.y));
        }
        ss += o[i].x * o[i].x + o[i].y * o[i].y + o[i].z * o[i].z + o[i].w * o[i].w;
      }
      ss = wave_sum(ss);
      const float rinv = rsqrtf(ss * (1.f / D) + 1e-6f);
#pragma unroll
      for (int i = 0; i < 4; ++i) {
        float4 g = *(const float4*)(pg + (i * 64 + lane) * 4);
        float4 t = *(const float4*)(gt + (i * 64 + lane) * 4);
        x[i].x += t.x * (o[i].x * rinv * g.x); x[i].y += t.y * (o[i].y * rinv * g.y);
        x[i].z += t.z * (o[i].z * rinv * g.z); x[i].w += t.w * (o[i].w * rinv * g.w);
        *(float4*)(xst + (i * 64 + lane) * 4) = x[i];
      }
    }
    if (pre) {
      const float* pg = p.in[pre == 1 ? I_FFNPRE : I_MIXPRE] + lpre * D;
      const float* sc = mod + (size_t)(lpre * 5 + bb) * 6144 + (pre == 1 ? 4096 : 1024);
      const float* sh = mod + (size_t)(lpre * 5 + bb) * 6144 + (pre == 1 ? 3072 : 0);
      u16* hout = (u16*)(p.ws + (pre == 1 ? OFF_HB : OFF_H1)) + (size_t)row * D;
      float ss = 0.f;
#pragma unroll
      for (int i = 0; i < 4; ++i) ss += x[i].x * x[i].x + x[i].y * x[i].y + x[i].z * x[i].z + x[i].w * x[i].w;
      ss = wave_sum(ss);
      const float rinv = rsqrtf(ss * (1.f / D) + 1e-6f);
#pragma unroll
      for (int i = 0; i < 4; ++i) {
        float4 g = *(const float4*)(pg + (i * 64 + lane) * 4);
        float4 c4 = *(const float4*)(sc + (i * 64 + lane) * 4);
        float4 h4 = *(const float4*)(sh + (i * 64 + lane) * 4);
        uint2 v;
        v.x = pack2(x[i].x * rinv * g.x * (1.f + c4.x) + h4.x, x[i].y * rinv * g.y * (1.f + c4.y) + h4.y);
        v.y = pack2(x[i].z * rinv * g.z * (1.f + c4.z) + h4.z, x[i].w * rinv * g.w * (1.f + c4.w) + h4.w);
        *(uint2*)(hout + (i * 64 + lane) * 4) = v;
      }
    }
  }
}


#define XCD_TILE_LOOP(MTN, NTN, PN_) \
  for (int x_ = blockIdx.x & 7, nsl_ = gridDim.x >> 3, mlo_ = x_ * (MTN) / 8, mtx_ = (x_ + 1) * (MTN) / 8 - mlo_, q_ = blockIdx.x >> 3; \
       q_ < mtx_ * (NTN); q_ += nsl_)
#define XCD_TILE_DECODE(NTN, PN_, MT_, NT_) \
  int MT_, NT_; { int p_ = q_ / (mtx_ * (PN_)); int rem_ = q_ - p_ * mtx_ * (PN_); int wp_ = min((PN_), (NTN) - p_ * (PN_)); \
    MT_ = mlo_ + rem_ / wp_; NT_ = p_ * (PN_) + rem_ % wp_; }

DI void rope_store_A(const Params& p, const float* T, u16* out, int row0, int col0, float scale) {
  const float* cosA = (const float*)(p.ws + OFF_ROPE);
  const float* sinA = cosA + 1024;
  for (int e = TIDX; e < 128 * 64; e += 256) {
    int i = e >> 6, j = 2 * (e & 63);
    int s = (row0 + i) % TT;
    float v0 = T[i * TS + j], v1 = T[i * TS + j + 1];
    if (s >= CTX) {
      int t = s - CTX, d = j & 63;
      int pos = (d < 32) ? (t >> 6) : (t & 63);
      int f = d & 15;
      float c0 = cosA[pos * 16 + f], s0 = sinA[pos * 16 + f], c1 = cosA[pos * 16 + f + 1], s1 = sinA[pos * 16 + f + 1];
      float p0 = T[i * TS + (j ^ 16)], p1 = T[i * TS + ((j + 1) ^ 16)];
      if (d & 16) { v0 = v0 * c0 + p0 * s0; v1 = v1 * c1 + p1 * s1; }
      else { v0 = v0 * c0 - p0 * s0; v1 = v1 * c1 - p1 * s1; }
    }
    *(unsigned*)(out + (size_t)(row0 + i) * 512 + col0 + j) = pack2(v0 * scale, v1 * scale);
  }
}
DI void phase_gemm_in(const Params& p, char* smem) {
  char* ws = p.ws;
  XCD_TILE_LOOP(MT, 24, 8) {
    XCD_TILE_DECODE(24, 8, mt, nt)
    const int row0 = mt * 128;
    gemm_tile((const u16*)(ws + OFF_H1), 1024, row0, 0, R, (const u16*)(ws + OFF_WT_IN) + (size_t)nt * 128 * 1024, 1024, 1024, smem);
    const float* T = (const float*)smem;
    if (nt < 4) rope_store_A(p, T, (u16*)(ws + OFF_QA), row0, nt * 128, 0.125f * LOG2E);
    else if (nt < 8) rope_store_A(p, T, (u16*)(ws + OFF_KA), row0, (nt - 4) * 128, 1.f);
    else if (nt < 12) { int b = row0 / TT, s0 = row0 % TT; store_bf16_T(T, 0, 128, (u16*)(ws + OFF_VTA) + ((size_t)b * 512 + (nt - 8) * 128) * TT, s0); }
    else if (nt < 15) store_bf16(T, 0, 128, (u16*)(ws + OFF_BRAW), 384, row0, (nt - 12) * 128);
    else store_bf16(T, 0, 128, (u16*)(ws + OFF_CRAW), 1152, row0, (nt - 15) * 128);
  }
}

DI void phase_prep(const Params& p, int l) {
  char* ws = p.ws;
  const int lane = TIDX & 63, wave = TIDX >> 6;
  const float* cosB = (const float*)(ws + OFF_ROPE) + 2048;
  const float* sinB = cosB + 512;
  for (int row = blockIdx.x * 4 + wave; row < R; row += gridDim.x * 4) {
    const int s = row % TT;
    u16* br = (u16*)(ws + OFF_BRAW) + (size_t)row * 384;
    {
      float v0 = bf2f(br[lane]), v1 = bf2f(br[64 + lane]), v2 = bf2f(br[128 + lane]);
      float w0 = bf2f(br[192 + lane]), w1 = bf2f(br[256 + lane]);
      float kr = lane < 32 ? bf2f(br[320 + lane]) : 0.f;
      float ssq = wave_sum(v0 * v0 + v1 * v1 + v2 * v2);
      float ssk = wave_sum(w0 * w0 + w1 * w1);
      float rq = rsqrtf(ssq * (1.f / 192.f) + 1e-6f), rk = rsqrtf(ssk * (1.f / 128.f) + 1e-6f);
      const float* gq = p.in[I_BQG] + l * 192;
      const float* gk = p.in[I_BKVG] + l * 128;
      br[lane] = f2bf(v0 * rq * gq[lane]); br[64 + lane] = f2bf(v1 * rq * gq[64 + lane]); br[128 + lane] = f2bf(v2 * rq * gq[128 + lane]);
      br[192 + lane] = f2bf(w0 * rk * gk[lane]); br[256 + lane] = f2bf(w1 * rk * gk[64 + lane]);
      float kp = __shfl_xor(kr, 8);
      if (s >= CTX) {
        int t = s - CTX, d = lane & 31;
        int pos = (d < 16) ? (t >> 6) : (t & 63);
        int f = d & 7;
        float c = cosB[pos * 8 + f], sn = sinB[pos * 8 + f];
        kr = (d & 8) ? kr * c + kp * sn : kr * c - kp * sn;
      }
      if (lane < 32) ((u16*)(ws + OFF_KR))[(size_t)row * 32 + lane] = f2bf(kr);
    }
    const bool hasprev = (s != 0 && s != CTX), hasnext = (s != CTX - 1 && s != TT - 1);
    const u16* cr = (const u16*)(ws + OFF_CRAW) + (size_t)row * 1152;
    u16* rk4 = (u16*)(ws + OFF_RKVK);
    u16* lora = (u16*)(ws + OFF_LORA) + (size_t)row * 384;
#pragma unroll
    for (int it = 0; it < 5; ++it) {
      const int g = it * 64 + lane;
      if (g < 288) {
        const int col = g * 4;
        uint2 cu = *(const uint2*)(cr + col);
        uint2 pu = hasprev ? *(const uint2*)(cr - 1152 + col) : make_uint2(0, 0);
        uint2 nu = hasnext ? *(const uint2*)(cr + 1152 + col) : make_uint2(0, 0);
        float4 mp = *(const float4*)(p.in[I_MUP] + l * 1152 + col);
        float4 mn = *(const float4*)(p.in[I_MUN] + l * 1152 + col);
        float c0 = lo_bf(cu.x), c1 = hi_bf(cu.x), c2 = lo_bf(cu.y), c3 = hi_bf(cu.y);
        float x0 = c0 + mp.x * (lo_bf(pu.x) - c0) + mn.x * (lo_bf(nu.x) - c0);
        float x1 = c1 + mp.y * (hi_bf(pu.x) - c1) + mn.y * (hi_bf(nu.x) - c1);
        float x2 = c2 + mp.z * (lo_bf(pu.y) - c2) + mn.z * (lo_bf(nu.y) - c2);
        float x3 = c3 + mp.w * (hi_bf(pu.y) - c3) + mn.w * (hi_bf(nu.y) - c3);
        if (it < 3) {
          const int c = col - it * 256;
          *(uint2*)(rk4 + (size_t)it * R * 256 + (size_t)row * 256 + c) = make_uint2(pack2(x0, x1), pack2(x2, x3));
          if (it == 1) {
            float4 kk = *(const float4*)(p.in[I_KK] + l * 256 + c);
            float k0 = x0 * kk.x, k1 = x1 * kk.y, k2 = x2 * kk.z, k3 = x3 * kk.w;
            float ss = k0 * k0 + k1 * k1 + k2 * k2 + k3 * k3;
            ss += __shfl_xor(ss, 1); ss += __shfl_xor(ss, 2); ss += __shfl_xor(ss, 4); ss += __shfl_xor(ss, 8);
            float inv = 1.f / fmaxf(sqrtf(ss), 1e-12f);
            *(uint2*)(rk4 + (size_t)3 * R * 256 + (size_t)row * 256 + c) = make_uint2(pack2(k0 * inv, k1 * inv), pack2(k2 * inv, k3 * inv));
          }
        } else if (it == 3) {
          const int c = col - 768;
          if (c < 128) {
            x0 = 1.f - 2.f / (__expf(2.f * x0) + 1.f); x1 = 1.f - 2.f / (__expf(2.f * x1) + 1.f);
            x2 = 1.f - 2.f / (__expf(2.f * x2) + 1.f); x3 = 1.f - 2.f / (__expf(2.f * x3) + 1.f);
          }
          *(uint2*)(lora + c) = make_uint2(pack2(x0, x1), pack2(x2, x3));
        } else {
          const int c = col - 1024;
          *(uint2*)(lora + 256 + c) = make_uint2(pack2(sigmoidf_(x0), sigmoidf_(x1)), pack2(sigmoidf_(x2), sigmoidf_(x3)));
        }
      }
    }
    *(float4*)((float*)(ws + OFF_YS) + (size_t)row * 256 + lane * 4) = make_float4(0.f, 0.f, 0.f, 0.f);
  }
}

DI void phase_small_gemms(const Params& p, int l, char* smem) {
  char* ws = p.ws;
  const float* cosB = (const float*)(ws + OFF_ROPE) + 2048;
  const float* sinB = cosB + 512;
  const float scaleB = 0.10206207261596575f * LOG2E;
  XCD_TILE_LOOP(MT, 17, 17) {
    XCD_TILE_DECODE(17, 17, mt, g)
    const int row0 = mt * 128;
    const float* T = (const float*)smem;
    if (g < 3) {
      gemm_tile((const u16*)(ws + OFF_BRAW), 384, row0, 0, R, (const u16*)(ws + OFF_WT_Q) + (size_t)g * 128 * 192, 192, 192, smem);
      u16* qb = (u16*)(ws + OFF_QB);
      for (int e = TIDX; e < 128 * 64; e += 256) {
        int i = e >> 6, j = 2 * (e & 63);
        float v0 = T[i * TS + j], v1 = T[i * TS + j + 1];
        int oc;
        if (g < 2) { int np = g * 128 + j; oc = (np >> 6) * 96 + (np & 63); }
        else {
          int h = j >> 5, dr = j & 31;
          oc = h * 96 + 64 + dr;
          int s = (row0 + i) % TT;
          if (s >= CTX) {
            int tt = s - CTX;
            int pos = (dr < 16) ? (tt >> 6) : (tt & 63);
            int f = dr & 7;
            float c0 = cosB[pos * 8 + f], s0 = sinB[pos * 8 + f], c1 = cosB[pos * 8 + f + 1], s1 = sinB[pos * 8 + f + 1];
            float p0 = T[i * TS + (j ^ 8)], p1 = T[i * TS + ((j + 1) ^ 8)];
            if (dr & 8) { v0 = v0 * c0 + p0 * s0; v1 = v1 * c1 + p1 * s1; }
            else { v0 = v0 * c0 - p0 * s0; v1 = v1 * c1 - p1 * s1; }
          }
        }
        *(unsigned*)(qb + (size_t)(row0 + i) * 384 + oc) = pack2(v0 * scaleB, v1 * scaleB);
      }
    } else if (g < 7) {
      const int h = g - 3;
      gemm_tile((const u16*)(ws + OFF_BRAW) + 192, 384, row0, 0, R, (const u16*)(ws + OFF_WT_KV) + (size_t)h * 128 * 128, 128, 128, smem);
      store_bf16(T, 0, 64, (u16*)(ws + OFF_KBN), 256, row0, h * 64);
      int b = row0 / TT, s0 = row0 % TT;
      store_bf16_T(T, 64, 64, (u16*)(ws + OFF_VTB) + ((size_t)b * 256 + h * 64) * TT, s0);
    } else if (g < 11) {
      const int d = (g - 7) >> 1, nt = (g - 7) & 1;
      gemm_tile((const u16*)(ws + OFF_LORA) + d * 64, 384, row0, 0, R, (const u16*)(ws + OFF_WT_W2) + (size_t)(d * 256 + nt * 128) * 64, 64, 64, smem);
      float* dec = (float*)(ws + OFF_DECAY) + (size_t)d * R * 256;
      const float* w0 = p.in[I_W0] + (l * 2 + d) * 256 + nt * 128;
      for (int e = TIDX; e < 128 * 128; e += 256) {
        int i = e >> 7, j = e & 127;
        dec[(size_t)(row0 + i) * 256 + nt * 128 + j] = __expf(-0.6065306597126334f * sigmoidf_(w0[j] + T[i * TS + j]));
      }
    } else if (g < 15) {
      const int d = (g - 11) >> 1, nt = (g - 11) & 1;
      gemm_tile((const u16*)(ws + OFF_LORA) + 128 + d * 64, 384, row0, 0, R, (const u16*)(ws + OFF_WT_A2) + (size_t)(d * 256 + nt * 128) * 64, 64, 64, smem);
      u16* ad = (u16*)(ws + OFF_AD) + (size_t)d * R * 256;
      const float* a0 = p.in[I_A0] + (l * 2 + d) * 256 + nt * 128;
      for (int e = TIDX; e < 128 * 64; e += 256) {
        int i = e >> 6, j = 2 * (e & 63);
        *(unsigned*)(ad + (size_t)(row0 + i) * 256 + nt * 128 + j) =
            pack2(sigmoidf_(a0[j] + T[i * TS + j]), sigmoidf_(a0[j + 1] + T[i * TS + j + 1]));
      }
    } else {
      const int nt = g - 15;
      gemm_tile((const u16*)(ws + OFF_LORA) + 256, 384, row0, 0, R, (const u16*)(ws + OFF_WT_G2) + (size_t)nt * 128 * 128, 128, 128, smem);
      store_bf16(T, 0, 128, (u16*)(ws + OFF_GATE), 256, row0, nt * 128);
    }
  }
}

DI float scan_chunk(const float* Vb, int sl, int st, f2_t& S01, f2_t& S23) {
  float4 w4 = *(const float4*)(Vb + sl * 4), kd4 = *(const float4*)(Vb + 64 + sl * 4), a4 = *(const float4*)(Vb + 128 + sl * 4);
  float4 b4 = *(const float4*)(Vb + 192 + sl * 4), r4 = *(const float4*)(Vb + 256 + sl * 4);
  float vv = Vb[320 + st];
  float ykeep = 0.f;
#pragma unroll
  for (int s2 = 0; s2 < 16; ++s2) {
    const float4 cw = w4, ckd = kd4, ca = a4, cb = b4, cr = r4; const float cv = vv;
    if (s2 + 1 < 16) {
      const float* P = Vb + (s2 + 1) * 336;
      w4 = *(const float4*)(P + sl * 4); kd4 = *(const float4*)(P + 64 + sl * 4); a4 = *(const float4*)(P + 128 + sl * 4);
      b4 = *(const float4*)(P + 192 + sl * 4); r4 = *(const float4*)(P + 256 + sl * 4); vv = P[320 + st];
    }
    const f2_t v2 = {cv, cv};
    const f2_t pre01 = __builtin_elementwise_fma(v2, (f2_t){ckd.x, ckd.y}, S01 * (f2_t){cw.x, cw.y});
    const f2_t pre23 = __builtin_elementwise_fma(v2, (f2_t){ckd.z, ckd.w}, S23 * (f2_t){cw.z, cw.w});
    f2_t sp = S01 * (f2_t){ca.x, ca.y};
    sp = __builtin_elementwise_fma(S23, (f2_t){ca.z, ca.w}, sp);
    float sa = sum16(sp.x + sp.y);
    const f2_t sa2 = {sa, sa};
    S01 = __builtin_elementwise_fma(sa2, (f2_t){cb.x, cb.y}, pre01);
    S23 = __builtin_elementwise_fma(sa2, (f2_t){cb.z, cb.w}, pre23);
    f2_t yp = S01 * (f2_t){cr.x, cr.y};
    yp = __builtin_elementwise_fma(S23, (f2_t){cr.z, cr.w}, yp);
    float y = sum16(yp.x + yp.y);
    ykeep = (s2 == sl) ? y : ykeep;
  }
  return ykeep;
}

typedef float f32x4v __attribute__((ext_vector_type(4)));
struct ScanStg { u32x2 r, k, kk, a; f32x4v d; u16 v; };
DI void scan_item(const Params& p, int l, int item, char* smem) {
  char* ws = p.ws;
  const int tid = TIDX;
  const int dir = item & 1, rg = (item >> 1) & 3, bh = item >> 3, b = bh >> 2, h = bh & 3;
  const int st = tid >> 4, sl = tid & 15;
  const u16* RB = (const u16*)(ws + OFF_RKVK);
  const u16* KB2 = RB + (size_t)R * 256;
  const u16* VB2 = KB2 + (size_t)R * 256;
  const u16* KKB = VB2 + (size_t)R * 256;
  const u16* AD = (const u16*)(ws + OFF_AD) + (size_t)dir * R * 256;
  const float* DEC = (const float*)(ws + OFF_DECAY) + (size_t)dir * R * 256;
  float* YS = (float*)(ws + OFF_YS);
  const float4 ka = *(const float4*)(p.in[I_KA] + l * 256 + h * 64 + sl * 4);
  const int colk = h * 64 + sl * 4, colv = h * 64 + rg * 16 + sl;
  f2_t S01 = {0.f, 0.f}, S23 = {0.f, 0.f};
  constexpr int NCH = TT / 16;
  __builtin_amdgcn_s_setprio(3);
  auto tok_of = [&](int j) -> int { return dir == 0 ? j : (j < CTX ? CTX - 1 - j : TT + CTX - 1 - j); };
#define SC_LOAD(S, CH) { const size_t ro = (size_t)(b * TT + tok_of((CH) * 16 + st)) * 256; \
    S.r = *(const u32x2*)(RB + ro + colk); S.k = *(const u32x2*)(KB2 + ro + colk); S.kk = *(const u32x2*)(KKB + ro + colk); \
    S.a = *(const u32x2*)(AD + ro + colk); S.d = *(const f32x4v*)(DEC + ro + colk); S.v = VB2[ro + colv]; }
#define SC_BODY(S, CH, YK) { \
    { float* V = (float*)(smem + ((CH) & 1) * 21504) + st * 336; \
      float k0 = lo_bf(S.k.x), k1 = hi_bf(S.k.x), k2 = lo_bf(S.k.y), k3 = hi_bf(S.k.y); \
      float a0 = lo_bf(S.a.x), a1 = hi_bf(S.a.x), a2 = lo_bf(S.a.y), a3 = hi_bf(S.a.y); \
      float q0 = lo_bf(S.kk.x), q1 = hi_bf(S.kk.x), q2 = lo_bf(S.kk.y), q3 = hi_bf(S.kk.y); \
      *(f32x4v*)(V + 0 * 64 + sl * 4) = S.d; \
      *(float4*)(V + 1 * 64 + sl * 4) = make_float4(k0 * (1.f + (a0 - 1.f) * ka.x), k1 * (1.f + (a1 - 1.f) * ka.y), \
                                                     k2 * (1.f + (a2 - 1.f) * ka.z), k3 * (1.f + (a3 - 1.f) * ka.w)); \
      *(float4*)(V + 2 * 64 + sl * 4) = make_float4(-q0, -q1, -q2, -q3); \
      *(float4*)(V + 3 * 64 + sl * 4) = make_float4(q0 * a0, q1 * a1, q2 * a2, q3 * a3); \
      *(float4*)(V + 4 * 64 + sl * 4) = make_float4(lo_bf(S.r.x), hi_bf(S.r.x), lo_bf(S.r.y), hi_bf(S.r.y)); \
      V[320 + sl] = bf2f(S.v); } \
    __syncthreads(); \
    SC_LOAD(S, min((CH) + 4, NCH - 1))     \
    YK = scan_chunk((const float*)(smem + ((CH) & 1) * 21504), sl, st, S01, S23); }
  ScanStg g0, g1, g2, g3;
  __syncthreads();
  SC_LOAD(g0, 0) asm volatile("" ::: "memory");
  SC_LOAD(g1, 1) asm volatile("" ::: "memory");
  SC_LOAD(g2, 2) asm volatile("" ::: "memory");
  SC_LOAD(g3, 3) asm volatile("" ::: "memory");
#define SC_YADD(CH, YK) unsafeAtomicAdd(YS + (size_t)(b * TT + tok_of((CH) * 16 + sl)) * 256 + h * 64 + rg * 16 + st, YK);
  for (int ch = 0; ch < NCH; ch += 4) {
    float y0, y1, y2, y3;
    SC_BODY(g0, ch, y0) SC_BODY(g1, ch + 1, y1) SC_BODY(g2, ch + 2, y2) SC_BODY(g3, ch + 3, y3)
    SC_YADD(ch, y0) SC_YADD(ch + 1, y1) SC_YADD(ch + 2, y2) SC_YADD(ch + 3, y3)
  }
#undef SC_YADD
#undef SC_LOAD
#undef SC_BODY
  __builtin_amdgcn_s_setprio(0);
}

template <bool DIFF>
DI void attn_item(const Params& p, int l, int item, char* smem) {
  char* ws = p.ws;
  constexpr int DQK = DIFF ? 64 : 96, KS = DQK / 16, DB = DIFF ? 4 : 2;
  constexpr int KROWB = DIFF ? 144 : 208;
  constexpr int KBYTES = DIFF ? 2 * 64 * 144 : 64 * 208;
  constexpr int VROWS = DIFF ? 128 : 64;
  constexpr int BUFB = KBYTES + VROWS * 144;
  constexpr int NCHK = DIFF ? 8 : 5;
  constexpr int QPB = DIFF ? 64 : 128;
  constexpr int NQB = TT / QPB, CTXB = CTX / QPB;
  const int tid = TIDX, lane = tid & 63, wave = tid >> 6, l32 = lane & 31, hf = lane >> 5;
  const int nact = (l == 0) ? NQB : NQB - CTXB;
  const int bh = item / nact, qb = item % nact + ((l == 0) ? 0 : CTXB);
  const int b = bh >> 2, h = bh & 3;
  const int q0 = qb * QPB;
  const int nkt = ((q0 < CTX) ? CTX : TT) / 64;
  const int m = DIFF ? (wave >> 1) : 0;
  const int qtok = q0 + (DIFF ? (wave & 1) : wave) * 32 + l32;
  const size_t qrow = (size_t)b * TT + qtok;

  bf16x8 qf[KS];
#pragma unroll
  for (int ks = 0; ks < KS; ++ks) {
    if (DIFF) qf[ks] = *(const bf16x8*)((const u16*)(ws + OFF_QA) + qrow * 512 + (h * 2 + m) * 64 + ks * 16 + hf * 8);
    else qf[ks] = *(const bf16x8*)((const u16*)(ws + OFF_QB) + qrow * 384 + h * 96 + ks * 16 + hf * 8);
  }
  f32x16 O[DB];
#pragma unroll
  for (int d = 0; d < DB; ++d)
#pragma unroll
    for (int r = 0; r < 16; ++r) O[d][r] = 0.f;
  float m_run = 0.f, l_run = 0.f;

  u32x4 stg[NCHK];
#define ATT_GLOAD(KT) \
  _Pragma("unroll") for (int i = 0; i < NCHK; ++i) { \
    const int c = tid + 256 * i; \
    const u16* src; \
    if (DIFF) { \
      if (i < 4) { int map = c >> 9, key = (c >> 3) & 63, chn = c & 7; \
        src = (const u16*)(ws + OFF_KA) + ((size_t)b * TT + (KT) * 64 + key) * 512 + (h * 2 + map) * 64 + chn * 8; } \
      else { int c2 = c - 1024, e = c2 >> 3, chn = c2 & 7; \
        src = (const u16*)(ws + OFF_VTA) + ((size_t)b * 512 + h * 128 + e) * TT + (KT) * 64 + chn * 8; } \
    } else { \
      if (i < 3) { int key = c / 12, chn = c % 12; \
        size_t kr = (size_t)b * TT + (KT) * 64 + key; \
        src = chn < 8 ? (const u16*)(ws + OFF_KBN) + kr * 256 + h * 64 + chn * 8 : (const u16*)(ws + OFF_KR) + kr * 32 + (chn - 8) * 8; } \
      else { int c2 = c - 768, e = c2 >> 3, chn = c2 & 7; \
        src = (const u16*)(ws + OFF_VTB) + ((size_t)b * 256 + h * 64 + e) * TT + (KT) * 64 + chn * 8; } \
    } \
    stg[i] = *(const u32x4*)src; \
  }
#define ATT_SSTORE(BUF) \
  _Pragma("unroll") for (int i = 0; i < NCHK; ++i) { \
    const int c = tid + 256 * i; \
    int off; \
    if (DIFF) { \
      if (i < 4) { int map = c >> 9, key = (c >> 3) & 63, chn = c & 7; int krow = (key & ~12) | ((key & 4) << 1) | ((key & 8) >> 1); off = map * 9216 + krow * 144 + chn * 16; } \
      else { int c2 = c - 1024, e = c2 >> 3, chn = c2 & 7; off = KBYTES + e * 144 + chn * 16; } \
    } else { \
      if (i < 3) { int key = c / 12, chn = c % 12; int krow = (key & ~12) | ((key & 4) << 1) | ((key & 8) >> 1); off = krow * 208 + chn * 16; } \
      else { int c2 = c - 768, e = c2 >> 3, chn = c2 & 7; off = KBYTES + e * 144 + chn * 16; } \
    } \
    *(u32x4*)(smem + (BUF) * BUFB + off) = stg[i]; \
  }
  __syncthreads();
  ATT_GLOAD(0)
  ATT_SSTORE(0)
  __syncthreads();
  for (int kt = 0; kt < nkt; ++kt) {
    if (kt + 1 < nkt) { ATT_GLOAD(kt + 1) }
    const char* sk = smem + (kt & 1) * BUFB + (DIFF ? m * 9216 : 0);
    const char* sv = smem + (kt & 1) * BUFB + KBYTES;
    f32x16 sc[2];
#pragma unroll
    for (int kb = 0; kb < 2; ++kb) {
#pragma unroll
      for (int r = 0; r < 16; ++r) sc[kb][r] = -m_run;
#pragma unroll
      for (int ks = 0; ks < KS; ++ks) {
        bf16x8 a = *(const bf16x8*)(sk + (kb * 32 + l32) * KROWB + (ks * 16 + hf * 8) * 2);
        sc[kb] = MFMA32(a, qf[ks], sc[kb]);
      }
    }
    float mx = sc[0][0];
#pragma unroll
    for (int r = 0; r < 16; ++r) { mx = fmaxf(mx, sc[0][r]); mx = fmaxf(mx, sc[1][r]); }
    {
      auto sw = __builtin_amdgcn_permlane32_swap(__float_as_uint(mx), __float_as_uint(mx), false, false);
      mx = fmaxf(__uint_as_float(sw[0]), __uint_as_float(sw[1]));
    }
    if (kt == 0 || __builtin_amdgcn_ballot_w64(mx > 8.f) != 0) {
      const float delta = (kt == 0) ? mx : fmaxf(mx, 0.f);
      const float alpha = (kt == 0) ? 1.f : __builtin_amdgcn_exp2f(-delta);
      m_run += delta;
      l_run *= alpha;
#pragma unroll
      for (int d = 0; d < DB; ++d)
#pragma unroll
        for (int r = 0; r < 16; ++r) O[d][r] *= alpha;
#pragma unroll
      for (int kb = 0; kb < 2; ++kb)
#pragma unroll
        for (int r = 0; r < 16; ++r) sc[kb][r] -= delta;
    }
    float psum = 0.f;
#pragma unroll
    for (int kb = 0; kb < 2; ++kb)
#pragma unroll
      for (int r = 0; r < 16; ++r) { float e = __builtin_amdgcn_exp2f(sc[kb][r]); sc[kb][r] = e; psum += e; }
    l_run += psum;
    bf16x8 pf[4];
#pragma unroll
    for (int s2 = 0; s2 < 4; ++s2) {
      const int kb = s2 >> 1, r0 = (s2 & 1) * 8;
      u32x4 u = {pack2(sc[kb][r0 + 0], sc[kb][r0 + 1]), pack2(sc[kb][r0 + 2], sc[kb][r0 + 3]),
                 pack2(sc[kb][r0 + 4], sc[kb][r0 + 5]), pack2(sc[kb][r0 + 6], sc[kb][r0 + 7])};
      pf[s2] = __builtin_bit_cast(bf16x8, u);
    }
#pragma unroll
    for (int d = 0; d < DB; ++d) {
#pragma unroll
      for (int s2 = 0; s2 < 4; ++s2) {
        const int kbase = (s2 >> 1) * 32 + (s2 & 1) * 16 + 8 * hf;
        const bf16x8 vf = *(const bf16x8*)(sv + (d * 32 + l32) * 144 + kbase * 2);
        O[d] = MFMA32(vf, pf[s2], O[d]);
      }
    }
    if (kt + 1 < nkt) { ATT_SSTORE((kt + 1) & 1) }
    __syncthreads();
  }
  const float ltot = l_run + __shfl_xor(l_run, 32);
  const float inv = 1.f / ltot;
  u16* cc = (u16*)(ws + OFF_HB) + qrow * 1024;
  if (DIFF) {
    float* X = (float*)smem;
    const int qs = wave & 1;
    if (m == 1) {
#pragma unroll
      for (int d = 0; d < DB; ++d)
#pragma unroll
        for (int r = 0; r < 16; ++r) X[((qs * 64 + d * 16 + r) << 6) + lane] = O[d][r] * inv;
    }
    __syncthreads();
    if (m == 0) {
      const float lam = ((const float*)(ws + OFF_SCAL))[l];
      const float oml = 1.f - ((const float*)(ws + OFF_SCAL))[2 + l];
      float ss = 0.f;
#pragma unroll
      for (int d = 0; d < DB; ++d)
#pragma unroll
        for (int r = 0; r < 16; ++r) {
          float o = O[d][r] * inv - lam * X[((qs * 64 + d * 16 + r) << 6) + lane];
          O[d][r] = o; ss += o * o;
        }
      ss += __shfl_xor(ss, 32);
      const float rinv = rsqrtf(ss * (1.f / 128.f) + 1e-5f) * oml;
      const float* sg = p.in[I_SUBLN] + l * 128;
#pragma unroll
      for (int d = 0; d < DB; ++d)
#pragma unroll
        for (int g = 0; g < 4; ++g) {
          const int e = d * 32 + 8 * g + 4 * hf;
          float4 gg = *(const float4*)(sg + e);
          uint2 v = make_uint2(pack2(O[d][4 * g] * rinv * gg.x, O[d][4 * g + 1] * rinv * gg.y),
                               pack2(O[d][4 * g + 2] * rinv * gg.z, O[d][4 * g + 3] * rinv * gg.w));
          *(uint2*)(cc + h * 128 + e) = v;
        }
    }
    __syncthreads();
  } else {
#pragma unroll
    for (int d = 0; d < DB; ++d)
#pragma unroll
      for (int g = 0; g < 4; ++g) {
        const int e = d * 32 + 8 * g + 4 * hf;
        uint2 v = make_uint2(pack2(O[d][4 * g] * inv, O[d][4 * g + 1] * inv), pack2(O[d][4 * g + 2] * inv, O[d][4 * g + 3] * inv));
        *(uint2*)(cc + 512 + h * 64 + e) = v;
      }
  }
}

DI void phase_mixers(const Params& p, int l, char* smem, unsigned xcc) {
  __shared__ int4 s_item4;
  int& s_item = s_item4.x;
  int* ctrs = (int*)(p.ws + OFF_SCAL + 64) + l * 8;
  const int nqA = (l == 0) ? 68 : 64, nqB = (l == 0) ? 34 : 32;
  const int total = 16 + 2 * nqA + 2 * nqB;
  for (int dx = 0; dx < 8; ++dx) {
    const int q = (xcc + dx) & 7;
    while (true) {
      __syncthreads();
      if (TIDX == 0) s_item = atomicAdd(ctrs + q, 1);
      __syncthreads();
      const int j = s_item;
      if (j >= total) break;
      if (j < 16) scan_item(p, l, (2 * q + (j >> 3)) * 8 + (j & 7), smem);
      else if (j < 16 + 2 * nqA) { const int jj = j - 16; attn_item<true>(p, l, (2 * q + jj / nqA) * nqA + jj % nqA, smem); }
      else { const int jj = j - 16 - 2 * nqA; attn_item<false>(p, l, (2 * q + jj / nqB) * nqB + jj % nqB, smem); }
    }
  }
}

DI void phase_rwkv_post(const Params& p, int l) {
  char* ws = p.ws;
  const int lane = TIDX & 63, wave = TIDX >> 6;
  const u16* RB = (const u16*)(ws + OFF_RKVK);
  const u16* KB2 = RB + (size_t)R * 256;
  const u16* VB2 = KB2 + (size_t)R * 256;
  const int c = lane * 4;
  const float4 ka = *(const float4*)(p.in[I_KA] + l * 256 + c);
  const float4 rk = *(const float4*)(p.in[I_RK] + l * 256 + c);
  const float4 gg = *(const float4*)(p.in[I_GNG] + l * 256 + c);
  const float4 gb = *(const float4*)(p.in[I_GNB] + l * 256 + c);
  for (int row = blockIdx.x * 4 + wave; row < R; row += gridDim.x * 4) {
    if (l == 1 && (row % TT) < CTX) continue;
    const size_t ro = (size_t)row * 256 + c;
    float4 y = *(const float4*)((const float*)(ws + OFF_YS) + ro);
    uint2 ru = *(const uint2*)(RB + ro), ku = *(const uint2*)(KB2 + ro), vu = *(const uint2*)(VB2 + ro);
    uint2 af = *(const uint2*)((const u16*)(ws + OFF_AD) + ro), ab = *(const uint2*)((const u16*)(ws + OFF_AD) + (size_t)R * 256 + ro);
    uint2 gu = *(const uint2*)((const u16*)(ws + OFF_GATE) + ro);
    float s1 = y.x + y.y + y.z + y.w;
    s1 = sum16(s1);
    const float mu = s1 * (1.f / 64.f);
    float d0 = y.x - mu, d1 = y.y - mu, d2 = y.z - mu, d3 = y.w - mu;
    float s2 = sum16(d0 * d0 + d1 * d1 + d2 * d2 + d3 * d3);
    const float rs = rsqrtf(s2 * (1.f / 64.f) + 64e-5f);
    float r0 = lo_bf(ru.x), r1 = hi_bf(ru.x), r2 = lo_bf(ru.y), r3 = hi_bf(ru.y);
    float k0 = lo_bf(ku.x), k1 = hi_bf(ku.x), k2 = lo_bf(ku.y), k3 = hi_bf(ku.y);
    float bsum = 0.f;
    {
      float a0 = lo_bf(af.x), a1 = hi_bf(af.x), a2 = lo_bf(af.y), a3 = hi_bf(af.y);
      bsum += r0 * k0 * (1.f + (a0 - 1.f) * ka.x) * rk.x + r1 * k1 * (1.f + (a1 - 1.f) * ka.y) * rk.y +
              r2 * k2 * (1.f + (a2 - 1.f) * ka.z) * rk.z + r3 * k3 * (1.f + (a3 - 1.f) * ka.w) * rk.w;
      a0 = lo_bf(ab.x); a1 = hi_bf(ab.x); a2 = lo_bf(ab.y); a3 = hi_bf(ab.y);
      bsum += r0 * k0 * (1.f + (a0 - 1.f) * ka.x) * rk.x + r1 * k1 * (1.f + (a1 - 1.f) * ka.y) * rk.y +
              r2 * k2 * (1.f + (a2 - 1.f) * ka.z) * rk.z + r3 * k3 * (1.f + (a3 - 1.f) * ka.w) * rk.w;
    }
    bsum = sum16(bsum);
    float o0 = (d0 * rs * gg.x + gb.x + bsum * lo_bf(vu.x)) * lo_bf(gu.x);
    float o1 = (d1 * rs * gg.y + gb.y + bsum * hi_bf(vu.x)) * hi_bf(gu.x);
    float o2 = (d2 * rs * gg.z + gb.z + bsum * lo_bf(vu.y)) * lo_bf(gu.y);
    float o3 = (d3 * rs * gg.w + gb.w + bsum * hi_bf(vu.y)) * hi_bf(gu.y);
    *(uint2*)((u16*)(ws + OFF_HB) + (size_t)row * 1024 + 768 + c) = make_uint2(pack2(o0, o1), pack2(o2, o3));
  }
}

DI void phase_gemm_raw(const Params& p, int l, const u16* A, int lda, const u16* Wt, int K, float* out, char* smem) {
  XCD_TILE_LOOP(128, 8, 8) {
    XCD_TILE_DECODE(8, 8, ma, nt)
    const int mt = (ma >> 5) * 34 + 2 + (ma & 31);
    const int row0 = mt * 128;
    gemm_tile(A, lda, row0, 0, R, Wt + (size_t)nt * 128 * K, K, K, smem);
    store_bf16((const float*)smem, 0, 128, (u16*)out, 1024, row0, nt * 128);
  }
  if (l == 0) {
    const int Kq = K >> 2;
    for (int it = blockIdx.x; it < 256; it += gridDim.x) {
      const int kq = it & 3, nt = (it >> 2) & 7, cm = it >> 5;
      const int row0 = (cm >> 1) * TT + (cm & 1) * 128;
      gemm_tile(A + kq * Kq, lda, row0, 0, R, Wt + (size_t)nt * 128 * K + kq * Kq, K, Kq, smem);
      store_bf16((const float*)smem, 0, 128, (u16*)(p.ws + OFF_PART) + (size_t)kq * 1024 * 1024, 1024, cm * 128, nt * 128);
    }
  }
}

DI void phase_ffn_up(const Params& p, int l, char* smem) {
  char* ws = p.ws;
  const float* cw = p.in[I_CONVW] + (size_t)l * 3 * 5632;
  const float* cb = p.in[I_CONVB] + (size_t)l * 5632;
  u16* act = (u16*)(ws + OFF_ACT);
  const int mtn = (l == 0) ? 144 : 132;
  XCD_TILE_LOOP(mtn, 44, 11) {
    XCD_TILE_DECODE(44, 11, ma, nt)
    const int b = (l == 0) ? ma / 36 : ma / 33, r = (l == 0) ? ma % 36 : 3 + ma % 33;
    int segbase, seglen, t0;
    if (r < 3) { segbase = b * TT; seglen = CTX; t0 = r * 126; }
    else { segbase = b * TT + CTX; seglen = SEQ; t0 = (r - 3) * 126; }
    gemm_tile((const u16*)(ws + OFF_HB), 1024, segbase + t0 - 1, segbase, segbase + seglen,
              (const u16*)(ws + OFF_WT_UP) + (size_t)nt * 128 * 1024, 1024, 1024, smem);
    const float* T = (const float*)smem;
    const int tid_ = TIDX;
    const int j = 2 * (tid_ & 31), i0 = 1 + (tid_ >> 5) * 16;
    const int cg0 = nt * 64 + j;
    float wg[2][3], wv[2][3], bg[2], bv[2];
#pragma unroll
    for (int q = 0; q < 2; ++q) {
#pragma unroll
      for (int k = 0; k < 3; ++k) { wg[q][k] = cw[k * 5632 + cg0 + q]; wv[q][k] = cw[k * 5632 + DFF + cg0 + q]; }
      bg[q] = cb[cg0 + q]; bv[q] = cb[DFF + cg0 + q];
    }
    float gp[2], gc[2], vp[2], vc[2];
#pragma unroll
    for (int q = 0; q < 2; ++q) {
      gp[q] = T[(i0 - 1) * TS + j + q]; vp[q] = T[(i0 - 1) * TS + 64 + j + q];
      gc[q] = T[i0 * TS + j + q];       vc[q] = T[i0 * TS + 64 + j + q];
    }
#pragma unroll 4
    for (int ii = 0; ii < 16; ++ii) {
      const int i = i0 + ii;
      if (i > 126) break;
      float gn[2], vn[2], res[2];
#pragma unroll
      for (int q = 0; q < 2; ++q) { gn[q] = T[(i + 1) * TS + j + q]; vn[q] = T[(i + 1) * TS + 64 + j + q]; }
#pragma unroll
      for (int q = 0; q < 2; ++q) {
        float g = wg[q][0] * gp[q] + wg[q][1] * gc[q] + wg[q][2] * gn[q] + bg[q];
        float v = wv[q][0] * vp[q] + wv[q][1] * vc[q] + wv[q][2] * vn[q] + bv[q];
        res[q] = g * __builtin_amdgcn_rcpf(1.f + __expf(-g)) * v;
        gp[q] = gc[q]; gc[q] = gn[q]; vp[q] = vc[q]; vc[q] = vn[q];
      }
      const int li = t0 - 1 + i;
      if (li < seglen) *(unsigned*)(act + (size_t)(segbase + li) * DFF + cg0) = pack2(res[0], res[1]);
    }
  }
}

#define XB_TMO      128
#define XB_XCNT(j)  (256  + 64 * (j))
#define XB_XSUB(j)  (1280 + 64 * (j))
#define XB_XGEN(j)  (2304 + 64 * (j))
#define XB_TOP      3328
#define XB_TOPGEN   3392
#define XCD_BAR_WORDS 3456
#define XB_SPIN_CAP (1u << 24)
#define LAS __attribute__((address_space(3)))
DI unsigned xb_ld(unsigned* p) { return __hip_atomic_load(p, __ATOMIC_RELAXED, __HIP_MEMORY_SCOPE_AGENT); }
DI unsigned xb_add(unsigned* p, unsigned v) { return __hip_atomic_fetch_add(p, v, __ATOMIC_RELAXED, __HIP_MEMORY_SCOPE_AGENT); }
DI unsigned xb_xcc_id() { return (unsigned)__builtin_amdgcn_s_getreg((3 << 11) | 20) & 0xFu; }
#define XB_SPIN(cond, bar) do { unsigned _sp = 0; while (cond) { __builtin_amdgcn_s_sleep(1); \
    if ((++_sp & 255u) == 0u) { if (xb_ld(&(bar)[XB_TMO])) break; if (_sp > XB_SPIN_CAP) { atomicAdd(&(bar)[XB_TMO], 1u); break; } } } } while (0)
struct XcdBarrier { unsigned* bar; unsigned x; volatile LAS unsigned* st; };
DI XcdBarrier xcd_barrier_post(unsigned* bar, volatile LAS unsigned* st) {
  XcdBarrier b; b.bar = bar; b.x = xb_xcc_id(); b.st = st;
  if (threadIdx.x == 0) (void)xb_add(&bar[XB_XCNT(b.x)], 1u);
  return b;
}
DI void xcd_barrier_complete(unsigned* bar, unsigned x, unsigned& nloc, unsigned& nx) {
  const unsigned G = gridDim.x * gridDim.y * gridDim.z;
  unsigned sum, cnt, mine, sp = 0u;
  for (;;) {
    sum = 0u; cnt = 0u; mine = 0u;
#pragma unroll
    for (unsigned j = 0; j < 16; ++j) { const unsigned c = xb_ld(&bar[XB_XCNT(j)]); sum += c; cnt += (c > 0u) ? 1u : 0u; mine = (j == x) ? c : mine; }
    if (sum == G) break;
    __builtin_amdgcn_s_sleep(1);
    if ((++sp & 255u) == 0u) { if (xb_ld(&bar[XB_TMO])) break; if (sp > XB_SPIN_CAP) { atomicAdd(&bar[XB_TMO], 1u); break; } }
  }
  nloc = mine > 0u ? mine : 1u; nx = cnt > 0u ? cnt : 1u;
}
DI void xcd_barrier(const XcdBarrier& b) {
  asm volatile("s_waitcnt vmcnt(0)" ::: "memory");
  __syncthreads();
  if (threadIdx.x == 0) {
    unsigned* bar = b.bar;
    __builtin_amdgcn_s_waitcnt(0);
    unsigned nloc = b.st[0], nx = b.st[1];
    if (nloc == 0u) { xcd_barrier_complete(bar, b.x, nloc, nx); b.st[0] = nloc; b.st[1] = nx; }
    const unsigned old = xb_add(&bar[XB_XSUB(b.x)], 1u);
    const unsigned gen = old / nloc;
    if (old + 1u == (gen + 1u) * nloc) {
      __builtin_amdgcn_fence(__ATOMIC_RELEASE, "agent");
      asm volatile("s_waitcnt vmcnt(0)" ::: "memory");
      const unsigned og = xb_add(&bar[XB_TOP], 1u);
      const unsigned tg = og / nx;
      if (og + 1u == (tg + 1u) * nx) xb_add(&bar[XB_TOPGEN], 1u);
      else XB_SPIN(xb_ld(&bar[XB_TOPGEN]) == tg, bar);
      __builtin_amdgcn_fence(__ATOMIC_ACQUIRE, "agent");
      xb_add(&bar[XB_XGEN(b.x)], 1u);
      asm volatile("s_waitcnt vmcnt(0)" ::: "memory");
    } else {
      XB_SPIN(xb_ld(&bar[XB_XGEN(b.x)]) == gen, bar);
      __builtin_amdgcn_fence(__ATOMIC_ACQUIRE, "agent");
      asm volatile("s_waitcnt vmcnt(0)" ::: "memory");
    }
  }
  __syncthreads();
}

__global__ void __launch_bounds__(256, 2) fwd_megakernel(Params p) {
  extern __shared__ __attribute__((aligned(16))) char smem[];
  cg::grid_group grid = cg::this_grid();
  char* ws = p.ws;
  __shared__ uint4 xb_words;
  if (threadIdx.x == 0) xb_words = make_uint4(0u, 0u, 0u, 0u);
  __syncthreads();
  XcdBarrier xb = xcd_barrier_post((unsigned*)(ws + OFF_BAR), (volatile LAS unsigned*)&xb_words);
  if (blockIdx.x == 0) misc_setup(p);
  if (gridDim.x > 256) {
    if (blockIdx.x < 192) mod_item(p, blockIdx.x, smem);
    else for (int it = blockIdx.x - 192; it < NCONV_MIX; it += gridDim.x - 192) convert_mix_item(p, 0, it, smem);
  } else {
    for (int it = blockIdx.x; it < 192 + NCONV_MIX; it += gridDim.x) {
      if (it < 192) mod_item(p, it, smem); else convert_mix_item(p, 0, it - 192, smem);
    }
  }
  if (p.ws == nullptr) grid.sync(); else xcd_barrier(xb);
  for (int l = 0; l < 2; ++l) {
    if (l == 0) norm_phase(p, 0, 0, 2, 0, true, false);
    else {
      norm_phase(p, 2, 0, 2, 1, false, false);
      for (int it = blockIdx.x; it < NCONV_MIX; it += gridDim.x) convert_mix_item(p, 1, it, smem);
    }
    xcd_barrier(xb);
    phase_gemm_in(p, smem);
    xcd_barrier(xb);
    phase_prep(p, l);
    xcd_barrier(xb);
    phase_small_gemms(p, l, smem);
    xcd_barrier(xb);
    phase_mixers(p, l, smem, xb.x);
    xcd_barrier(xb);
    phase_rwkv_post(p, l);
    xcd_barrier(xb);
    phase_gemm_raw(p, l, (const u16*)(ws + OFF_HB), 1024, (const u16*)(ws + OFF_WT_OUT), 1024, (float*)(ws + OFF_RAW), smem);
    xcd_barrier(xb);
    norm_phase(p, 1, l, 1, l, l == 0, l == 1);
    for (int it = blockIdx.x; it < NCONV_FFN; it += gridDim.x) convert_ffn_item(p, l, it, smem);
    xcd_barrier(xb);
    phase_ffn_up(p, l, smem);
    xcd_barrier(xb);
    phase_gemm_raw(p, l, (const u16*)(ws + OFF_ACT), DFF, (const u16*)(ws + OFF_WT_DOWN), DFF, (float*)(ws + OFF_RAW2), smem);
    xcd_barrier(xb);
  }
  norm_phase(p, 2, 1, 0, 0, false, true);
}

extern "C" void kernel_launch(void* const* d_in, const int* in_sizes, int n_in, void* d_out, int out_size,
                              void* d_ws, size_t ws_size, hipStream_t stream) {
  static int grid_blocks = 0;
  if (!grid_blocks) {
    int dev = 0, cus = 0, per_cu = 0;
    hipGetDevice(&dev);
    hipDeviceGetAttribute(&cus, hipDeviceAttributeMultiprocessorCount, dev);
    hipFuncSetAttribute((const void*)fwd_megakernel, hipFuncAttributeMaxDynamicSharedMemorySize, SMEM_BYTES);
    hipOccupancyMaxActiveBlocksPerMultiprocessor(&per_cu, fwd_megakernel, 256, SMEM_BYTES);
    if (per_cu > 2) per_cu = 2;
    if (per_cu < 1) per_cu = 1;
    grid_blocks = cus * per_cu;
  }
  hipMemsetAsync((char*)d_ws + OFF_BAR, 0, XCD_BAR_WORDS * 4, stream);
  Params p{};
  for (int i = 0; i < N_INPUTS; ++i) p.in[i] = (const float*)d_in[i];
  p.out = (float*)d_out;
  p.ws = (char*)d_ws;
  void* args[] = {&p};
  hipError_t e = hipLaunchCooperativeKernel((const void*)fwd_megakernel, dim3(grid_blocks), dim3(256), args, SMEM_BYTES, stream);
  if (e != hipSuccess) fprintf(stderr, "cooperative launch failed: %s (grid %d)\n", hipGetErrorString(e), grid_blocks);
}
```

```cpp
#include <hip/hip_runtime.h>
#include <hip/hip_cooperative_groups.h>
#include <stdint.h>
#include <stdio.h>
namespace cg = cooperative_groups;

#define DI __device__ __forceinline__
typedef unsigned short u16;
typedef __attribute__((ext_vector_type(8))) short bf16x8;
typedef __attribute__((ext_vector_type(4))) short s16x4;
typedef __attribute__((ext_vector_type(16))) float f32x16;
typedef __bf16 bf2_t __attribute__((ext_vector_type(2)));
typedef float f2_t __attribute__((ext_vector_type(2)));
typedef unsigned u32x4 __attribute__((ext_vector_type(4)));
typedef unsigned u32x2 __attribute__((ext_vector_type(2)));

constexpr int D = 1024, NB = 4, SEQ = 4096, CTX = 256, TT = SEQ + CTX, R = NB * TT, MT = R / 128;
constexpr int DFF = 2816;
constexpr float LOG2E = 1.4426950408889634f;

enum { I_X = 0, I_C, I_CTX, I_CCTX, I_ADAW, I_ADAB, I_MIXPRE, I_MIXPOST, I_FFNPRE, I_FFNPOST, I_WIN, I_WOUT,
       I_LQ1, I_LK1, I_LQ2, I_LK2, I_SUBLN, I_BQG, I_BWQ, I_BKVG, I_BWKV, I_MUP, I_MUN, I_W0, I_W2, I_A0, I_A2,
       I_G2, I_KK, I_KA, I_RK, I_GNG, I_GNB, I_WUP, I_CONVW, I_CONVB, I_WDOWN, N_INPUTS };

struct Params { const float* in[N_INPUTS]; float* out; char* ws; };

constexpr size_t al(size_t x) { return (x + 255) & ~size_t(255); }
constexpr size_t OFF_MOD = 0;
constexpr size_t OFF_SCAL = OFF_MOD + al(2 * 5 * 6144 * 4);
constexpr size_t OFF_BAR = OFF_SCAL + 1024;
constexpr size_t OFF_ROPE = OFF_BAR + 16384;
constexpr size_t OFF_KR = OFF_ROPE + al(3072 * 4);
constexpr size_t OFF_XC = OFF_KR + al((size_t)R * 32 * 2);
constexpr size_t OFF_WMIX = OFF_XC + al((size_t)1024 * 1024 * 4);
constexpr size_t OFF_WT_IN = OFF_WMIX;
constexpr size_t OFF_WT_OUT = OFF_WT_IN + (size_t)3072 * 1024 * 2;
constexpr size_t OFF_WT_Q = OFF_WT_OUT + (size_t)1024 * 1024 * 2;
constexpr size_t OFF_WT_KV = OFF_WT_Q + (size_t)384 * 192 * 2;
constexpr size_t OFF_WT_W2 = OFF_WT_KV + (size_t)512 * 128 * 2;
constexpr size_t OFF_WT_A2 = OFF_WT_W2 + (size_t)2 * 256 * 64 * 2;
constexpr size_t OFF_WT_G2 = OFF_WT_A2 + (size_t)2 * 256 * 64 * 2;
constexpr size_t OFF_HB = al(OFF_WT_G2 + (size_t)256 * 128 * 2);
constexpr size_t OFF_BRAW = OFF_HB;
constexpr size_t OFF_LORA = OFF_HB + (size_t)R * 384 * 2;
constexpr size_t OFF_QA = OFF_HB + (size_t)R * 1024 * 2;
constexpr size_t OFF_KA = OFF_QA + (size_t)R * 512 * 2;
constexpr size_t OFF_VTA = OFF_KA + (size_t)R * 512 * 2;
constexpr size_t OFF_CRAW = OFF_VTA + (size_t)R * 512 * 2;
constexpr size_t OFF_DECAY = OFF_CRAW;
constexpr size_t OFF_QB = OFF_CRAW + (size_t)R * 1152 * 2;
constexpr size_t OFF_KBN = OFF_QB + (size_t)R * 384 * 2;
constexpr size_t OFF_VTB = OFF_KBN + (size_t)R * 256 * 2;
constexpr size_t OFF_AD = OFF_VTB + (size_t)R * 256 * 2;
constexpr size_t OFF_GATE = OFF_AD + (size_t)2 * R * 256 * 2;
constexpr size_t OFF_YS = OFF_GATE + (size_t)R * 256 * 2;
constexpr size_t OFF_RKVK = OFF_YS + (size_t)R * 256 * 4;
constexpr size_t OFF_H1 = OFF_RKVK;
constexpr size_t OFF_WT_UP = OFF_RKVK;
constexpr size_t OFF_WT_DOWN = OFF_WT_UP + (size_t)5632 * 1024 * 2;
constexpr size_t OFF_PART = OFF_RKVK + (size_t)R * 1024 * 2;
constexpr size_t OFF_END = OFF_PART + (size_t)4 * 1024 * 1024 * 2;
constexpr size_t OFF_RAW = OFF_QA;
constexpr size_t OFF_ACT = OFF_QA;
constexpr size_t OFF_RAW2 = OFF_ACT + (size_t)R * DFF * 2;
static_assert(OFF_RAW2 + (size_t)R * 1024 * 4 <= OFF_RKVK, "raw2 overlap");
static_assert(OFF_RAW + (size_t)R * 1024 * 4 <= OFF_QB, "raw overlap");
static_assert(OFF_WT_DOWN + (size_t)1024 * DFF * 2 <= OFF_PART, "ffn weights");
static_assert(OFF_END <= (size_t)256 * 1024 * 1024, "workspace");
static_assert((size_t)2 * R * 256 * 4 <= (size_t)R * 1152 * 2, "decay fits craw");

constexpr int SMEM_BYTES = 73728;
constexpr int TS = 133;

DI int opaque_tid() { int t = threadIdx.x; asm volatile("" : "+v"(t)); return t; }
#define TIDX opaque_tid()
DI float bf2f(u16 v) { return __uint_as_float(((unsigned)v) << 16); }
DI unsigned pack2(float a, float b) { f2_t v = {a, b}; bf2_t r = __builtin_convertvector(v, bf2_t); return __builtin_bit_cast(unsigned, r); }
DI u16 f2bf(float a) { return (u16)(pack2(a, 0.f) & 0xffffu); }
DI float lo_bf(unsigned u) { return __uint_as_float(u << 16); }
DI float hi_bf(unsigned u) { return __uint_as_float(u & 0xffff0000u); }
DI float wave_sum(float x) {
#pragma unroll
  for (int o = 32; o > 0; o >>= 1) x += __shfl_xor(x, o);
  return x;
}
template <int CTRL> DI float dpp_add(float x) {
  int v = __builtin_amdgcn_update_dpp(0, __float_as_int(x), CTRL, 0xF, 0xF, true);
  return x + __int_as_float(v);
}
DI float sum16(float x) {
  x = dpp_add<0xB1>(x); x = dpp_add<0x4E>(x); x = dpp_add<0x141>(x); x = dpp_add<0x140>(x);
  return x;
}
DI int crow(int reg, int hf) { return (reg & 3) + 8 * (reg >> 2) + 4 * hf; }
DI float sigmoidf_(float x) { return __builtin_amdgcn_rcpf(1.f + __expf(-x)); }
#define MFMA32(a, b, c) __builtin_amdgcn_mfma_f32_32x32x16_bf16((a), (b), (c), 0, 0, 0)

DI void gemm_tile(const u16* __restrict__ A, int lda, int arow0, int alo, int ahi,
                  const u16* __restrict__ Bt, int ldb, int K, char* smem) {
  const int tid = TIDX, lane = tid & 63, wave = tid >> 6, wm = wave >> 1, wn = wave & 1, l32 = lane & 31, hf = lane >> 5;
  const int srow = tid >> 3, sch = tid & 7;
  f32x16 acc[2][2];
#pragma unroll
  for (int i = 0; i < 2; ++i)
#pragma unroll
    for (int j = 0; j < 2; ++j)
#pragma unroll
      for (int r = 0; r < 16; ++r) acc[i][j][r] = 0.f;
  u32x4 ra0[4], rb0[4], ra1[4], rb1[4];
  const u32x4 z4 = {0u, 0u, 0u, 0u};
  const u16* ap[4]; const u16* bp[4]; bool av[4];
#pragma unroll
  for (int i = 0; i < 4; ++i) {
    int row = srow + 32 * i, ar = arow0 + row;
    int arc = min(max(ar, alo), ahi - 1);
    av[i] = (ar == arc);
    ap[i] = A + (size_t)arc * lda + sch * 8;
    bp[i] = Bt + (size_t)row * ldb + sch * 8;
  }
  const int nk = K >> 6;
#define G_LOAD(RA, RB, KT) \
  _Pragma("unroll") for (int i = 0; i < 4; ++i) { u32x4 va = *(const u32x4*)(ap[i] + (KT) * 64); if (!av[i]) va = z4; RA[i] = va; RB[i] = *(const u32x4*)(bp[i] + (KT) * 64); }
#define G_STORE(RA, RB, BUF) \
  _Pragma("unroll") for (int i = 0; i < 4; ++i) { int row = srow + 32 * i; \
    *(u32x4*)(smem + (BUF) * 36864 + row * 144 + sch * 16) = RA[i]; *(u32x4*)(smem + (BUF) * 36864 + 18432 + row * 144 + sch * 16) = RB[i]; }
#define G_COMPUTE(BUF) { \
    const char* sa = smem + (BUF) * 36864; const char* sb = sa + 18432; \
    _Pragma("unroll") for (int ks = 0; ks < 4; ++ks) { \
      const int ko = (ks * 16 + hf * 8) * 2; \
      bf16x8 a0 = *(const bf16x8*)(sa + (wm * 64 + l32) * 144 + ko); \
      bf16x8 a1 = *(const bf16x8*)(sa + (wm * 64 + 32 + l32) * 144 + ko); \
      bf16x8 b0 = *(const bf16x8*)(sb + (wn * 64 + l32) * 144 + ko); \
      bf16x8 b1 = *(const bf16x8*)(sb + (wn * 64 + 32 + l32) * 144 + ko); \
      acc[0][0] = MFMA32(a0, b0, acc[0][0]); acc[0][1] = MFMA32(a0, b1, acc[0][1]); \
      acc[1][0] = MFMA32(a1, b0, acc[1][0]); acc[1][1] = MFMA32(a1, b1, acc[1][1]); } }
  __syncthreads();
  G_LOAD(ra0, rb0, 0)
  if (nk > 1) { G_LOAD(ra1, rb1, 1) }
  G_STORE(ra0, rb0, 0)
  __syncthreads();
  for (int kt = 0; kt < nk; kt += 2) {
    if (kt + 2 < nk) { G_LOAD(ra0, rb0, kt + 2) }
    G_COMPUTE(0)
    if (kt + 1 < nk) { G_STORE(ra1, rb1, 1) }
    __syncthreads();
    if (kt + 1 < nk) {
      if (kt + 3 < nk) { G_LOAD(ra1, rb1, kt + 3) }
      G_COMPUTE(1)
      if (kt + 2 < nk) { G_STORE(ra0, rb0, 0) }
      __syncthreads();
    }
  }
#undef G_LOAD
#undef G_STORE
#undef G_COMPUTE
  float* T = (float*)smem;
#pragma unroll
  for (int mi = 0; mi < 2; ++mi)
#pragma unroll
    for (int ni = 0; ni < 2; ++ni)
#pragma unroll
      for (int r = 0; r < 16; ++r)
        T[(wm * 64 + mi * 32 + crow(r, hf)) * TS + wn * 64 + ni * 32 + l32] = acc[mi][ni][r];
  __syncthreads();
}

DI void store_bf16(const float* T, int jc0, int ncols, u16* out, size_t ld, int row0, int col0) {
  const int np = ncols >> 1, sh = (ncols == 128) ? 6 : 5;
  for (int e = TIDX; e < 128 * np; e += 256) {
    int i = e >> sh, j = 2 * (e & (np - 1));
    *(unsigned*)(out + (size_t)(row0 + i) * ld + col0 + j) = pack2(T[i * TS + jc0 + j], T[i * TS + jc0 + j + 1]);
  }
}
DI void store_bf16_T(const float* T, int jc0, int ncols, u16* out, int s0) {
  for (int e = TIDX; e < ncols * 64; e += 256) {
    int c = e >> 6, i2 = e & 63;
    *(unsigned*)(out + (size_t)c * TT + s0 + 2 * i2) = pack2(T[(2 * i2) * TS + jc0 + c], T[(2 * i2 + 1) * TS + jc0 + c]);
  }
}

DI int srccol(int mode, int np) {
  if (mode == 1) return np < 1888 ? np : (np < 1920 ? -1 : np - 32);
  if (mode == 2) { if (np < 256) return (np >> 6) * 96 + (np & 63); int j = np - 256; return (j >> 5) * 96 + 64 + (j & 31); }
  if (mode == 3) { int t = np >> 7, j = np & 127; return j < 64 ? t * 64 + j : DFF + t * 64 + j - 64; }
  return np;
}
DI void convert_tile(const float* __restrict__ src, int ldw, int k0, int n0, u16* __restrict__ dst, int ldd, int mode, char* smem) {
  float* T = (float*)smem;
  const int tid = TIDX;
  __syncthreads();
  {
    const int r0 = tid >> 4, c4 = (tid & 15) * 4;
    const int sc = srccol(mode, n0 + c4);
    float4 v[4];
#pragma unroll
    for (int ps = 0; ps < 4; ++ps)
      v[ps] = sc < 0 ? make_float4(0.f, 0.f, 0.f, 0.f) : *(const float4*)(src + (size_t)(k0 + ps * 16 + r0) * ldw + sc);
#pragma unroll
    for (int ps = 0; ps < 4; ++ps) {
      float* t = T + (ps * 16 + r0) * 65 + c4;
      t[0] = v[ps].x; t[1] = v[ps].y; t[2] = v[ps].z; t[3] = v[ps].w;
    }
  }
  __syncthreads();
#pragma unroll
  for (int it = 0; it < 2; ++it) {
    int nn = it * 32 + (tid >> 3), kc = tid & 7;
    uint4 v;
    v.x = pack2(T[(kc * 8 + 0) * 65 + nn], T[(kc * 8 + 1) * 65 + nn]);
    v.y = pack2(T[(kc * 8 + 2) * 65 + nn], T[(kc * 8 + 3) * 65 + nn]);
    v.z = pack2(T[(kc * 8 + 4) * 65 + nn], T[(kc * 8 + 5) * 65 + nn]);
    v.w = pack2(T[(kc * 8 + 6) * 65 + nn], T[(kc * 8 + 7) * 65 + nn]);
    *(uint4*)(dst + (size_t)(n0 + nn) * ldd + k0 + kc * 8) = v;
  }
}
constexpr int NCONV_MIX = 768 + 256 + 18 + 16 + 8 + 8 + 8;
DI void convert_mix_item(const Params& p, int l, int it, char* smem) {
  char* ws = p.ws;
  if (it < 768) { convert_tile(p.in[I_WIN] + (size_t)l * 1024 * 3040, 3040, (it / 48) * 64, (it % 48) * 64, (u16*)(ws + OFF_WT_IN), 1024, 1, smem); return; }
  it -= 768;
  if (it < 256) { convert_tile(p.in[I_WOUT] + (size_t)l * 1024 * 1024, 1024, (it / 16) * 64, (it % 16) * 64, (u16*)(ws + OFF_WT_OUT), 1024, 0, smem); return; }
  it -= 256;
  if (it < 18) { convert_tile(p.in[I_BWQ] + (size_t)l * 192 * 384, 384, (it / 6) * 64, (it % 6) * 64, (u16*)(ws + OFF_WT_Q), 192, 2, smem); return; }
  it -= 18;
  if (it < 16) { convert_tile(p.in[I_BWKV] + (size_t)l * 128 * 512, 512, (it / 8) * 64, (it % 8) * 64, (u16*)(ws + OFF_WT_KV), 128, 0, smem); return; }
  it -= 16;
  if (it < 8) { int d = it >> 2; convert_tile(p.in[I_W2] + (size_t)(l * 2 + d) * 64 * 256, 256, 0, (it & 3) * 64, (u16*)(ws + OFF_WT_W2) + d * 256 * 64, 64, 0, smem); return; }
  it -= 8;
  if (it < 8) { int d = it >> 2; convert_tile(p.in[I_A2] + (size_t)(l * 2 + d) * 64 * 256, 256, 0, (it & 3) * 64, (u16*)(ws + OFF_WT_A2) + d * 256 * 64, 64, 0, smem); return; }
  it -= 8;
  convert_tile(p.in[I_G2] + (size_t)l * 128 * 256, 256, (it / 4) * 64, (it % 4) * 64, (u16*)(ws + OFF_WT_G2), 128, 0, smem);
}
constexpr int NCONV_FFN = 16 * 88 + 44 * 16;
DI void convert_ffn_item(const Params& p, int l, int it, char* smem) {
  char* ws = p.ws;
  if (it < 1408) { convert_tile(p.in[I_WUP] + (size_t)l * 1024 * 5632, 5632, (it / 88) * 64, (it % 88) * 64, (u16*)(ws + OFF_WT_UP), 1024, 3, smem); return; }
  it -= 1408;
  convert_tile(p.in[I_WDOWN] + (size_t)l * DFF * 1024, 1024, (it / 16) * 64, (it % 16) * 64, (u16*)(ws + OFF_WT_DOWN), DFF, 0, smem);
}

DI void mod_item(const Params& p, int item, char* smem) {
  const int tid = TIDX, lane = tid & 63, kg = tid >> 6, c32 = lane & 31, kh = lane >> 5;
  const int l = item / 192, cb = item % 192;
  float* act = (float*)smem;
  float* red = act + 5 * 1024;
  __syncthreads();
  for (int i = tid; i < 5120; i += 256) {
    int bb = i >> 10, k = i & 1023;
    float v = bb < 4 ? p.in[I_C][bb * 1024 + k] : p.in[I_CCTX][k];
    act[i] = v / (1.f + __expf(-v));
  }
  __syncthreads();
  float a0 = 0, a1 = 0, a2 = 0, a3 = 0, a4 = 0;
  const float* W = p.in[I_ADAW] + ((size_t)l * 1024 + kg * 256 + kh * 128) * 6144 + cb * 32 + c32;
  const float* ac = act + kg * 256 + kh * 128;
#pragma unroll 32
  for (int k = 0; k < 128; ++k) {
    float w = W[(size_t)k * 6144];
    a0 += ac[k] * w; a1 += ac[1024 + k] * w; a2 += ac[2048 + k] * w; a3 += ac[3072 + k] * w; a4 += ac[4096 + k] * w;
  }
  const int g8 = kg * 2 + kh;
  red[(g8 * 5 + 0) * 32 + c32] = a0; red[(g8 * 5 + 1) * 32 + c32] = a1; red[(g8 * 5 + 2) * 32 + c32] = a2;
  red[(g8 * 5 + 3) * 32 + c32] = a3; red[(g8 * 5 + 4) * 32 + c32] = a4;
  __syncthreads();
  float* mod = (float*)(p.ws + OFF_MOD);
  for (int idx = tid; idx < 160; idx += 256) {
    int bb = idx >> 5, c = idx & 31;
    float sm = 0.f;
#pragma unroll
    for (int g = 0; g < 8; ++g) sm += red[(g * 5 + bb) * 32 + c];
    mod[(size_t)(l * 5 + bb) * 6144 + cb * 32 + c] = sm + p.in[I_ADAB][l * 6144 + cb * 32 + c];
  }
}
DI void misc_setup(const Params& p) {
  const int tid = TIDX;
  float* rope = (float*)(p.ws + OFF_ROPE);
  for (int i = tid; i < 1024; i += 256) {
    int pos = i >> 4, f = i & 15;
    float inv = exp2f(-(float)f * (13.287712379549449f / 16.f));
    float a = (float)pos * inv;
    rope[i] = cosf(a); rope[1024 + i] = sinf(a);
  }
  for (int i = tid; i < 512; i += 256) {
    int pos = i >> 3, f = i & 7;
    float inv = exp2f(-(float)f * (13.287712379549449f / 8.f));
    float a = (float)pos * inv;
    rope[2048 + i] = cosf(a); rope[2560 + i] = sinf(a);
  }
  if (tid < 16) ((int*)(p.ws + OFF_SCAL + 64))[tid] = 0;
  if (tid < 2) {
    int l = tid;
    float s1 = 0, s2 = 0;
    for (int i = 0; i < 64; ++i) {
      s1 += p.in[I_LQ1][l * 64 + i] * p.in[I_LK1][l * 64 + i];
      s2 += p.in[I_LQ2][l * 64 + i] * p.in[I_LK2][l * 64 + i];
    }
    float lam_init = 0.8f - 0.6f * expf(-0.3f * (float)l);
    ((float*)(p.ws + OFF_SCAL))[l] = expf(s1) - expf(s2) + lam_init;
    ((float*)(p.ws + OFF_SCAL))[2 + l] = lam_init;
  }
}

DI void norm_phase(const Params& p, int post, int lpost, int pre, int lpre, bool xin_input, bool skip_ctx) {
  const int lane = TIDX & 63, wave = TIDX >> 6;
  const float* mod = (const float*)(p.ws + OFF_MOD);
  for (int row = blockIdx.x * 4 + wave; row < R; row += gridDim.x * 4) {
    const int b = row / TT, s = row % TT;
    const bool isctx = s < CTX;
    if (isctx && skip_ctx) continue;
    const int bb = isctx ? 4 : b;
    const float* xin;
    float* xst = isctx ? (float*)(p.ws + OFF_XC) + (size_t)(b * CTX + s) * D : p.out + (size_t)(b * SEQ + s - CTX) * D;
    if (xin_input) xin = isctx ? p.in[I_CTX] + (size_t)(b * CTX + s) * D : p.in[I_X] + (size_t)(b * SEQ + s - CTX) * D;
    else xin = xst;
    float4 x[4];
#pragma unroll
    for (int i = 0; i < 4; ++i) x[i] = *(const float4*)(xin + (i * 64 + lane) * 4);
    if (post) {
      const u16* raw = (const u16*)(p.ws + (post == 1 ? OFF_RAW : OFF_RAW2)) + (size_t)row * D;
      const float* pg = p.in[post == 1 ? I_MIXPOST : I_FFNPOST] + lpost * D;
      const float* gt = mod + (size_t)(lpost * 5 + bb) * 6144 + (post == 1 ? 2048 : 5120);
      float4 o[4];
      float ss = 0.f;
#pragma unroll
      for (int i = 0; i < 4; ++i) {
        if (isctx) {
          const u16* pp = (const u16*)(p.ws + OFF_PART) + (size_t)(b * CTX + s) * D + (i * 64 + lane) * 4;
          o[i] = make_float4(0.f, 0.f, 0.f, 0.f);
#pragma unroll
          for (int q = 0; q < 4; ++q) {
            const uint2 ru = *(const uint2*)(pp + (size_t)q * 1024 * 1024);
            o[i].x += lo_bf(ru.x); o[i].y += hi_bf(ru.x); o[i].z += lo_bf(ru.y); o[i].w += hi_bf(ru.y);
          }
        } else {
          const uint2 ru = *(const uint2*)(raw + (i * 64 + lane) * 4);
          o[i] = make_float4(lo_bf(ru.x), hi_bf(ru.x), lo_bf(ru.y), hi_bf(ru.y));
        }
        ss += o[i].x * o[i].x + o[i].y * o[i].y + o[i].z * o[i].z + o[i].w * o[i].w;
      }
      ss = wave_sum(ss);
      const float rinv = rsqrtf(ss * (1.f / D) + 1e-6f);
#pragma unroll
      for (int i = 0; i < 4; ++i) {
        float4 g = *(const float4*)(pg + (i * 64 + lane) * 4);
        float4 t = *(const float4*)(gt + (i * 64 + lane) * 4);
        x[i].x += t.x * (o[i].x * rinv * g.x); x[i].y += t.y * (o[i].y * rinv * g.y);
        x[i].z += t.z * (o[i].z * rinv * g.z); x[i].w += t.w * (o[i].w * rinv * g.w);
        *(float4*)(xst + (i * 64 + lane) * 4) = x[i];
      }
    }
    if (pre) {
      const float* pg = p.in[pre == 1 ? I_FFNPRE : I_MIXPRE] + lpre * D;
      const float* sc = mod + (size_t)(lpre * 5 + bb) * 6144 + (pre == 1 ? 4096 : 1024);
      const float* sh = mod + (size_t)(lpre * 5 + bb) * 6144 + (pre == 1 ? 3072 : 0);
      u16* hout = (u16*)(p.ws + (pre == 1 ? OFF_HB : OFF_H1)) + (size_t)row * D;
      float ss = 0.f;
#pragma unroll
      for (int i = 0; i < 4; ++i) ss += x[i].x * x[i].x + x[i].y * x[i].y + x[i].z * x[i].z + x[i].w * x[i].w;
      ss = wave_sum(ss);
      const float rinv = rsqrtf(ss * (1.f / D) + 1e-6f);
#pragma unroll
      for (int i = 0; i < 4; ++i) {
        float4 g = *(const float4*)(pg + (i * 64 + lane) * 4);
        float4 c4 = *(const float4*)(sc + (i * 64 + lane) * 4);
        float4 h4 = *(const float4*)(sh + (i * 64 + lane) * 4);
        uint2 v;
        v.x = pack2(x[i].x * rinv * g.x * (1.f + c4.x) + h4.x, x[i].y * rinv * g.y * (1.f + c4.y) + h4.y);
        v.y = pack2(x[i].z * rinv * g.z * (1.f + c4.z) + h4.z, x[i].w * rinv * g.w * (1.f + c4.w) + h4.w);
        *(uint2*)(hout + (i * 64 + lane) * 4) = v;
      }
    }
  }
}


#define XCD_TILE_LOOP(MTN, NTN, PN_) \
  for (int x_ = blockIdx.x & 7, nsl_ = gridDim.x >> 3, mlo_ = x_ * (MTN) / 8, mtx_ = (x_ + 1) * (MTN) / 8 - mlo_, q_ = blockIdx.x >> 3; \
       q_ < mtx_ * (NTN); q_ += nsl_)
#define XCD_TILE_DECODE(NTN, PN_, MT_, NT_) \
  int MT_, NT_; { int p_ = q_ / (mtx_ * (PN_)); int rem_ = q_ - p_ * mtx_ * (PN_); int wp_ = min((PN_), (NTN) - p_ * (PN_)); \
    MT_ = mlo_ + rem_ / wp_; NT_ = p_ * (PN_) + rem_ % wp_; }

DI void rope_store_A(const Params& p, const float* T, u16* out, int row0, int col0, float scale) {
  const float* cosA = (const float*)(p.ws + OFF_ROPE);
  const float* sinA = cosA + 1024;
  for (int e = TIDX; e < 128 * 64; e += 256) {
    int i = e >> 6, j = 2 * (e & 63);
    int s = (row0 + i) % TT;
    float v0 = T[i * TS + j], v1 = T[i * TS + j + 1];
    if (s >= CTX) {
      int t = s - CTX, d = j & 63;
      int pos = (d < 32) ? (t >> 6) : (t & 63);
      int f = d & 15;
      float c0 = cosA[pos * 16 + f], s0 = sinA[pos * 16 + f], c1 = cosA[pos * 16 + f + 1], s1 = sinA[pos * 16 + f + 1];
      float p0 = T[i * TS + (j ^ 16)], p1 = T[i * TS + ((j + 1) ^ 16)];
      if (d & 16) { v0 = v0 * c0 + p0 * s0; v1 = v1 * c1 + p1 * s1; }
      else { v0 = v0 * c0 - p0 * s0; v1 = v1 * c1 - p1 * s1; }
    }
    *(unsigned*)(out + (size_t)(row0 + i) * 512 + col0 + j) = pack2(v0 * scale, v1 * scale);
  }
}
DI void phase_gemm_in(const Params& p, char* smem) {
  char* ws = p.ws;
  XCD_TILE_LOOP(MT, 24, 8) {
    XCD_TILE_DECODE(24, 8, mt, nt)
    const int row0 = mt * 128;
    gemm_tile((const u16*)(ws + OFF_H1), 1024, row0, 0, R, (const u16*)(ws + OFF_WT_IN) + (size_t)nt * 128 * 1024, 1024, 1024, smem);
    const float* T = (const float*)smem;
    if (nt < 4) rope_store_A(p, T, (u16*)(ws + OFF_QA), row0, nt * 128, 0.125f * LOG2E);
    else if (nt < 8) rope_store_A(p, T, (u16*)(ws + OFF_KA), row0, (nt - 4) * 128, 1.f);
    else if (nt < 12) { int b = row0 / TT, s0 = row0 % TT; store_bf16_T(T, 0, 128, (u16*)(ws + OFF_VTA) + ((size_t)b * 512 + (nt - 8) * 128) * TT, s0); }
    else if (nt < 15) store_bf16(T, 0, 128, (u16*)(ws + OFF_BRAW), 384, row0, (nt - 12) * 128);
    else store_bf16(T, 0, 128, (u16*)(ws + OFF_CRAW), 1152, row0, (nt - 15) * 128);
  }
}

DI void phase_prep(const Params& p, int l) {
  char* ws = p.ws;
  const int lane = TIDX & 63, wave = TIDX >> 6;
  const float* cosB = (const float*)(ws + OFF_ROPE) + 2048;
  const float* sinB = cosB + 512;
  for (int row = blockIdx.x * 4 + wave; row < R; row += gridDim.x * 4) {
    const int s = row % TT;
    u16* br = (u16*)(ws + OFF_BRAW) + (size_t)row * 384;
    {
      float v0 = bf2f(br[lane]), v1 = bf2f(br[64 + lane]), v2 = bf2f(br[128 + lane]);
      float w0 = bf2f(br[192 + lane]), w1 = bf2f(br[256 + lane]);
      float kr = lane < 32 ? bf2f(br[320 + lane]) : 0.f;
      float ssq = wave_sum(v0 * v0 + v1 * v1 + v2 * v2);
      float ssk = wave_sum(w0 * w0 + w1 * w1);
      float rq = rsqrtf(ssq * (1.f / 192.f) + 1e-6f), rk = rsqrtf(ssk * (1.f / 128.f) + 1e-6f);
      const float* gq = p.in[I_BQG] + l * 192;
      const float* gk = p.in[I_BKVG] + l * 128;
      br[lane] = f2bf(v0 * rq * gq[lane]); br[64 + lane] = f2bf(v1 * rq * gq[64 + lane]); br[128 + lane] = f2bf(v2 * rq * gq[128 + lane]);
      br[192 + lane] = f2bf(w0 * rk * gk[lane]); br[256 + lane] = f2bf(w1 * rk * gk[64 + lane]);
      float kp = __shfl_xor(kr, 8);
      if (s >= CTX) {
        int t = s - CTX, d = lane & 31;
        int pos = (d < 16) ? (t >> 6) : (t & 63);
        int f = d & 7;
        float c = cosB[pos * 8 + f], sn = sinB[pos * 8 + f];
        kr = (d & 8) ? kr * c + kp * sn : kr * c - kp * sn;
      }
      if (lane < 32) ((u16*)(ws + OFF_KR))[(size_t)row * 32 + lane] = f2bf(kr);
    }
    const bool hasprev = (s != 0 && s != CTX), hasnext = (s != CTX - 1 && s != TT - 1);
    const u16* cr = (const u16*)(ws + OFF_CRAW) + (size_t)row * 1152;
    u16* rk4 = (u16*)(ws + OFF_RKVK);
    u16* lora = (u16*)(ws + OFF_LORA) + (size_t)row * 384;
#pragma unroll
    for (int it = 0; it < 5; ++it) {
      const int g = it * 64 + lane;
      if (g < 288) {
        const int col = g * 4;
        uint2 cu = *(const uint2*)(cr + col);
        uint2 pu = hasprev ? *(const uint2*)(cr - 1152 + col) : make_uint2(0, 0);
        uint2 nu = hasnext ? *(const uint2*)(cr + 1152 + col) : make_uint2(0, 0);
        float4 mp = *(const float4*)(p.in[I_MUP] + l * 1152 + col);
        float4 mn = *(const float4*)(p.in[I_MUN] + l * 1152 + col);
        float c0 = lo_bf(cu.x), c1 = hi_bf(cu.x), c2 = lo_bf(cu.y), c3 = hi_bf(cu.y);
        float x0 = c0 + mp.x * (lo_bf(pu.x) - c0) + mn.x * (lo_bf(nu.x) - c0);
        float x1 = c1 + mp.y * (hi_bf(pu.x) - c1) + mn.y * (hi_bf(nu.x) - c1);
        float x2 = c2 + mp.z * (lo_bf(pu.y) - c2) + mn.z * (lo_bf(nu.y) - c2);
        float x3 = c3 + mp.w * (hi_bf(pu.y) - c3) + mn.w * (hi_bf(nu.y) - c3);
        if (it < 3) {
          const int c = col - it * 256;
          *(uint2*)(rk4 + (size_t)it * R * 256 + (size_t)row * 256 + c) = make_uint2(pack2(x0, x1), pack2(x2, x3));
          if (it == 1) {
            float4 kk = *(const float4*)(p.in[I_KK] + l * 256 + c);
            float k0 = x0 * kk.x, k1 = x1 * kk.y, k2 = x2 * kk.z, k3 = x3 * kk.w;
            float ss = k0 * k0 + k1 * k1 + k2 * k2 + k3 * k3;
            ss += __shfl_xor(ss, 1); ss += __shfl_xor(ss, 2); ss += __shfl_xor(ss, 4); ss += __shfl_xor(ss, 8);
            float inv = 1.f / fmaxf(sqrtf(ss), 1e-12f);
            *(uint2*)(rk4 + (size_t)3 * R * 256 + (size_t)row * 256 + c) = make_uint2(pack2(k0 * inv, k1 * inv), pack2(k2 * inv, k3 * inv));
          }
        } else if (it == 3) {
          const int c = col - 768;
          if (c < 128) {
            x0 = 1.f - 2.f / (__expf(2.f * x0) + 1.f); x1 = 1.f - 2.f / (__expf(2.f * x1) + 1.f);
            x2 = 1.f - 2.f / (__expf(2.f * x2) + 1.f); x3 = 1.f - 2.f / (__expf(2.f * x3) + 1.f);
          }
          *(uint2*)(lora + c) = make_uint2(pack2(x0, x1), pack2(x2, x3));
        } else {
          const int c = col - 1024;
          *(uint2*)(lora + 256 + c) = make_uint2(pack2(sigmoidf_(x0), sigmoidf_(x1)), pack2(sigmoidf_(x2), sigmoidf_(x3)));
        }
      }
    }
    *(float4*)((float*)(ws + OFF_YS) + (size_t)row * 256 + lane * 4) = make_float4(0.f, 0.f, 0.f, 0.f);
  }
}

DI void phase_small_gemms(const Params& p, int l, char* smem) {
  char* ws = p.ws;
  const float* cosB = (const float*)(ws + OFF_ROPE) + 2048;
  const float* sinB = cosB + 512;
  const float scaleB = 0.10206207261596575f * LOG2E;
  XCD_TILE_LOOP(MT, 17, 17) {
    XCD_TILE_DECODE(17, 17, mt, g)
    const int row0 = mt * 128;
    const float* T = (const float*)smem;
    if (g < 3) {
      gemm_tile((const u16*)(ws + OFF_BRAW), 384, row0, 0, R, (const u16*)(ws + OFF_WT_Q) + (size_t)g * 128 * 192, 192, 192, smem);
      u16* qb = (u16*)(ws + OFF_QB);
      for (int e = TIDX; e < 128 * 64; e += 256) {
        int i = e >> 6, j = 2 * (e & 63);
        float v0 = T[i * TS + j], v1 = T[i * TS + j + 1];
        int oc;
        if (g < 2) { int np = g * 128 + j; oc = (np >> 6) * 96 + (np & 63); }
        else {
          int h = j >> 5, dr = j & 31;
          oc = h * 96 + 64 + dr;
          int s = (row0 + i) % TT;
          if (s >= CTX) {
            int tt = s - CTX;
            int pos = (dr < 16) ? (tt >> 6) : (tt & 63);
            int f = dr & 7;
            float c0 = cosB[pos * 8 + f], s0 = sinB[pos * 8 + f], c1 = cosB[pos * 8 + f + 1], s1 = sinB[pos * 8 + f + 1];
            float p0 = T[i * TS + (j ^ 8)], p1 = T[i * TS + ((j + 1) ^ 8)];
            if (dr & 8) { v0 = v0 * c0 + p0 * s0; v1 = v1 * c1 + p1 * s1; }
            else { v0 = v0 * c0 - p0 * s0; v1 = v1 * c1 - p1 * s1; }
          }
        }
        *(unsigned*)(qb + (size_t)(row0 + i) * 384 + oc) = pack2(v0 * scaleB, v1 * scaleB);
      }
    } else if (g < 7) {
      const int h = g - 3;
      gemm_tile((const u16*)(ws + OFF_BRAW) + 192, 384, row0, 0, R, (const u16*)(ws + OFF_WT_KV) + (size_t)h * 128 * 128, 128, 128, smem);
      store_bf16(T, 0, 64, (u16*)(ws + OFF_KBN), 256, row0, h * 64);
      int b = row0 / TT, s0 = row0 % TT;
      store_bf16_T(T, 64, 64, (u16*)(ws + OFF_VTB) + ((size_t)b * 256 + h * 64) * TT, s0);
    } else if (g < 11) {
      const int d = (g - 7) >> 1, nt = (g - 7) & 1;
      gemm_tile((const u16*)(ws + OFF_LORA) + d * 64, 384, row0, 0, R, (const u16*)(ws + OFF_WT_W2) + (size_t)(d * 256 + nt * 128) * 64, 64, 64, smem);
      float* dec = (float*)(ws + OFF_DECAY) + (size_t)d * R * 256;
      const float* w0 = p.in[I_W0] + (l * 2 + d) * 256 + nt * 128;
      for (int e = TIDX; e < 128 * 128; e += 256) {
        int i = e >> 7, j = e & 127;
        dec[(size_t)(row0 + i) * 256 + nt * 128 + j] = __expf(-0.6065306597126334f * sigmoidf_(w0[j] + T[i * TS + j]));
      }
    } else if (g < 15) {
      const int d = (g - 11) >> 1, nt = (g - 11) & 1;
      gemm_tile((const u16*)(ws + OFF_LORA) + 128 + d * 64, 384, row0, 0, R, (const u16*)(ws + OFF_WT_A2) + (size_t)(d * 256 + nt * 128) * 64, 64, 64, smem);
      u16* ad = (u16*)(ws + OFF_AD) + (size_t)d * R * 256;
      const float* a0 = p.in[I_A0] + (l * 2 + d) * 256 + nt * 128;
      for (int e = TIDX; e < 128 * 64; e += 256) {
        int i = e >> 6, j = 2 * (e & 63);
        *(unsigned*)(ad + (size_t)(row0 + i) * 256 + nt * 128 + j) =
            pack2(sigmoidf_(a0[j] + T[i * TS + j]), sigmoidf_(a0[j + 1] + T[i * TS + j + 1]));
      }
    } else {
      const int nt = g - 15;
      gemm_tile((const u16*)(ws + OFF_LORA) + 256, 384, row0, 0, R, (const u16*)(ws + OFF_WT_G2) + (size_t)nt * 128 * 128, 128, 128, smem);
      store_bf16(T, 0, 128, (u16*)(ws + OFF_GATE), 256, row0, nt * 128);
    }
  }
}

DI float scan_chunk(const float* Vb, int sl, int st, f2_t& S01, f2_t& S23) {
  float4 w4 = *(const float4*)(Vb + sl * 4), kd4 = *(const float4*)(Vb + 64 + sl * 4), a4 = *(const float4*)(Vb + 128 + sl * 4);
  float4 b4 = *(const float4*)(Vb + 192 + sl * 4), r4 = *(const float4*)(Vb + 256 + sl * 4);
  float vv = Vb[320 + st];
  float ykeep = 0.f;
#pragma unroll
  for (int s2 = 0; s2 < 16; ++s2) {
    const float4 cw = w4, ckd = kd4, ca = a4, cb = b4, cr = r4; const float cv = vv;
    if (s2 + 1 < 16) {
      const float* P = Vb + (s2 + 1) * 336;
      w4 = *(const float4*)(P + sl * 4); kd4 = *(const float4*)(P + 64 + sl * 4); a4 = *(const float4*)(P + 128 + sl * 4);
      b4 = *(const float4*)(P + 192 + sl * 4); r4 = *(const float4*)(P + 256 + sl * 4); vv = P[320 + st];
    }
    const f2_t v2 = {cv, cv};
    const f2_t pre01 = __builtin_elementwise_fma(v2, (f2_t){ckd.x, ckd.y}, S01 * (f2_t){cw.x, cw.y});
    const f2_t pre23 = __builtin_elementwise_fma(v2, (f2_t){ckd.z, ckd.w}, S23 * (f2_t){cw.z, cw.w});
    f2_t sp = S01 * (f2_t){ca.x, ca.y};
    sp = __builtin_elementwise_fma(S23, (f2_t){ca.z, ca.w}, sp);
    float sa = sum16(sp.x + sp.y);
    const f2_t sa2 = {sa, sa};
    S01 = __builtin_elementwise_fma(sa2, (f2_t){cb.x, cb.y}, pre01);
    S23 = __builtin_elementwise_fma(sa2, (f2_t){cb.z, cb.w}, pre23);
    f2_t yp = S01 * (f2_t){cr.x, cr.y};
    yp = __builtin_elementwise_fma(S23, (f2_t){cr.z, cr.w}, yp);
    float y = sum16(yp.x + yp.y);
    ykeep = (s2 == sl) ? y : ykeep;
  }
  return ykeep;
}

typedef float f32x4v __attribute__((ext_vector_type(4)));
struct ScanStg { u32x2 r, k, kk, a; f32x4v d; u16 v; };
DI void scan_item(const Params& p, int l, int item, char* smem) {
  char* ws = p.ws;
  const int tid = TIDX;
  const int dir = item & 1, rg = (item >> 1) & 3, bh = item >> 3, b = bh >> 2, h = bh & 3;
  const int st = tid >> 4, sl = tid & 15;
  const u16* RB = (const u16*)(ws + OFF_RKVK);
  const u16* KB2 = RB + (size_t)R * 256;
  const u16* VB2 = KB2 + (size_t)R * 256;
  const u16* KKB = VB2 + (size_t)R * 256;
  const u16* AD = (const u16*)(ws + OFF_AD) + (size_t)dir * R * 256;
  const float* DEC = (const float*)(ws + OFF_DECAY) + (size_t)dir * R * 256;
  float* YS = (float*)(ws + OFF_YS);
  const float4 ka = *(const float4*)(p.in[I_KA] + l * 256 + h * 64 + sl * 4);
  const int colk = h * 64 + sl * 4, colv = h * 64 + rg * 16 + sl;
  f2_t S01 = {0.f, 0.f}, S23 = {0.f, 0.f};
  constexpr int NCH = TT / 16;
  __builtin_amdgcn_s_setprio(3);
  auto tok_of = [&](int j) -> int { return dir == 0 ? j : (j < CTX ? CTX - 1 - j : TT + CTX - 1 - j); };
#define SC_LOAD(S, CH) { const size_t ro = (size_t)(b * TT + tok_of((CH) * 16 + st)) * 256; \
    S.r = *(const u32x2*)(RB + ro + colk); S.k = *(const u32x2*)(KB2 + ro + colk); S.kk = *(const u32x2*)(KKB + ro + colk); \
    S.a = *(const u32x2*)(AD + ro + colk); S.d = *(const f32x4v*)(DEC + ro + colk); S.v = VB2[ro + colv]; }
#define SC_BODY(S, CH, YK) { \
    { float* V = (float*)(smem + ((CH) & 1) * 21504) + st * 336; \
      float k0 = lo_bf(S.k.x), k1 = hi_bf(S.k.x), k2 = lo_bf(S.k.y), k3 = hi_bf(S.k.y); \
      float a0 = lo_bf(S.a.x), a1 = hi_bf(S.a.x), a2 = lo_bf(S.a.y), a3 = hi_bf(S.a.y); \
      float q0 = lo_bf(S.kk.x), q1 = hi_bf(S.kk.x), q2 = lo_bf(S.kk.y), q3 = hi_bf(S.kk.y); \
      *(f32x4v*)(V + 0 * 64 + sl * 4) = S.d; \
      *(float4*)(V + 1 * 64 + sl * 4) = make_float4(k0 * (1.f + (a0 - 1.f) * ka.x), k1 * (1.f + (a1 - 1.f) * ka.y), \
                                                     k2 * (1.f + (a2 - 1.f) * ka.z), k3 * (1.f + (a3 - 1.f) * ka.w)); \
      *(float4*)(V + 2 * 64 + sl * 4) = make_float4(-q0, -q1, -q2, -q3); \
      *(float4*)(V + 3 * 64 + sl * 4) = make_float4(q0 * a0, q1 * a1, q2 * a2, q3 * a3); \
      *(float4*)(V + 4 * 64 + sl * 4) = make_float4(lo_bf(S.r.x), hi_bf(S.r.x), lo_bf(S.r.y), hi_bf(S.r.y)); \
      V[320 + sl] = bf2f(S.v); } \
    __syncthreads(); \
    SC_LOAD(S, min((CH) + 4, NCH - 1))     \
    YK = scan_chunk((const float*)(smem + ((CH) & 1) * 21504), sl, st, S01, S23); }
  ScanStg g0, g1, g2, g3;
  __syncthreads();
  SC_LOAD(g0, 0) asm volatile("" ::: "memory");
  SC_LOAD(g1, 1) asm volatile("" ::: "memory");
  SC_LOAD(g2, 2) asm volatile("" ::: "memory");
  SC_LOAD(g3, 3) asm volatile("" ::: "memory");
#define SC_YADD(CH, YK) unsafeAtomicAdd(YS + (size_t)(b * TT + tok_of((CH) * 16 + sl)) * 256 + h * 64 + rg * 16 + st, YK);
  for (int ch = 0; ch < NCH; ch += 4) {
    float y0, y1, y2, y3;
    SC_BODY(g0, ch, y0) SC_BODY(g1, ch + 1, y1) SC_BODY(g2, ch + 2, y2) SC_BODY(g3, ch + 3, y3)
    SC_YADD(ch, y0) SC_YADD(ch + 1, y1) SC_YADD(ch + 2, y2) SC_YADD(ch + 3, y3)
  }
#undef SC_YADD
#undef SC_LOAD
#undef SC_BODY
  __builtin_amdgcn_s_setprio(0);
}

template <bool DIFF>
DI void attn_item(const Params& p, int l, int item, char* smem) {
  char* ws = p.ws;
  constexpr int DQK = DIFF ? 64 : 96, KS = DQK / 16, DB = DIFF ? 4 : 2;
  constexpr int KROWB = DIFF ? 144 : 208;
  constexpr int KBYTES = DIFF ? 2 * 64 * 144 : 64 * 208;
  constexpr int VROWS = DIFF ? 128 : 64;
  constexpr int BUFB = KBYTES + VROWS * 144;
  constexpr int NCHK = DIFF ? 8 : 5;
  constexpr int QPB = DIFF ? 64 : 128;
  constexpr int NQB = TT / QPB, CTXB = CTX / QPB;
  const int tid = TIDX, lane = tid & 63, wave = tid >> 6, l32 = lane & 31, hf = lane >> 5;
  const int nact = (l == 0) ? NQB : NQB - CTXB;
  const int bh = item / nact, qb = item % nact + ((l == 0) ? 0 : CTXB);
  const int b = bh >> 2, h = bh & 3;
  const int q0 = qb * QPB;
  const int nkt = ((q0 < CTX) ? CTX : TT) / 64;
  const int m = DIFF ? (wave >> 1) : 0;
  const int qtok = q0 + (DIFF ? (wave & 1) : wave) * 32 + l32;
  const size_t qrow = (size_t)b * TT + qtok;

  bf16x8 qf[KS];
#pragma unroll
  for (int ks = 0; ks < KS; ++ks) {
    if (DIFF) qf[ks] = *(const bf16x8*)((const u16*)(ws + OFF_QA) + qrow * 512 + (h * 2 + m) * 64 + ks * 16 + hf * 8);
    else qf[ks] = *(const bf16x8*)((const u16*)(ws + OFF_QB) + qrow * 384 + h * 96 + ks * 16 + hf * 8);
  }
  f32x16 O[DB];
#pragma unroll
  for (int d = 0; d < DB; ++d)
#pragma unroll
    for (int r = 0; r < 16; ++r) O[d][r] = 0.f;
  float m_run = 0.f, l_run = 0.f;

  u32x4 stg[NCHK];
#define ATT_GLOAD(KT) \
  _Pragma("unroll") for (int i = 0; i < NCHK; ++i) { \
    const int c = tid + 256 * i; \
    const u16* src; \
    if (DIFF) { \
      if (i < 4) { int map = c >> 9, key = (c >> 3) & 63, chn = c & 7; \
        src = (const u16*)(ws + OFF_KA) + ((size_t)b * TT + (KT) * 64 + key) * 512 + (h * 2 + map) * 64 + chn * 8; } \
      else { int c2 = c - 1024, e = c2 >> 3, chn = c2 & 7; \
        src = (const u16*)(ws + OFF_VTA) + ((size_t)b * 512 + h * 128 + e) * TT + (KT) * 64 + chn * 8; } \
    } else { \
      if (i < 3) { int key = c / 12, chn = c % 12; \
        size_t kr = (size_t)b * TT + (KT) * 64 + key; \
        src = chn < 8 ? (const u16*)(ws + OFF_KBN) + kr * 256 + h * 64 + chn * 8 : (const u16*)(ws + OFF_KR) + kr * 32 + (chn - 8) * 8; } \
      else { int c2 = c - 768, e = c2 >> 3, chn = c2 & 7; \
        src = (const u16*)(ws + OFF_VTB) + ((size_t)b * 256 + h * 64 + e) * TT + (KT) * 64 + chn * 8; } \
    } \
    stg[i] = *(const u32x4*)src; \
  }
#define ATT_SSTORE(BUF) \
  _Pragma("unroll") for (int i = 0; i < NCHK; ++i) { \
    const int c = tid + 256 * i; \
    int off; \
    if (DIFF) { \
      if (i < 4) { int map = c >> 9, key = (c >> 3) & 63, chn = c & 7; int krow = (key & ~12) | ((key & 4) << 1) | ((key & 8) >> 1); off = map * 9216 + krow * 144 + chn * 16; } \
      else { int c2 = c - 1024, e = c2 >> 3, chn = c2 & 7; off = KBYTES + e * 144 + chn * 16; } \
    } else { \
      if (i < 3) { int key = c / 12, chn = c % 12; int krow = (key & ~12) | ((key & 4) << 1) | ((key & 8) >> 1); off = krow * 208 + chn * 16; } \
      else { int c2 = c - 768, e = c2 >> 3, chn = c2 & 7; off = KBYTES + e * 144 + chn * 16; } \
    } \
    *(u32x4*)(smem + (BUF) * BUFB + off) = stg[i]; \
  }
  __syncthreads();
  ATT_GLOAD(0)
  ATT_SSTORE(0)
  __syncthreads();
  for (int kt = 0; kt < nkt; ++kt) {
    if (kt + 1 < nkt) { ATT_GLOAD(kt + 1) }
    const char* sk = smem + (kt & 1) * BUFB + (DIFF ? m * 9216 : 0);
    const char* sv = smem + (kt & 1) * BUFB + KBYTES;
    f32x16 sc[2];
#pragma unroll
    for (int kb = 0; kb < 2; ++kb) {
#pragma unroll
      for (int r = 0; r < 16; ++r) sc[kb][r] = -m_run;
#pragma unroll
      for (int ks = 0; ks < KS; ++ks) {
        bf16x8 a = *(const bf16x8*)(sk + (kb * 32 + l32) * KROWB + (ks * 16 + hf * 8) * 2);
        sc[kb] = MFMA32(a, qf[ks], sc[kb]);
      }
    }
    float mx = sc[0][0];
#pragma unroll
    for (int r = 0; r < 16; ++r) { mx = fmaxf(mx, sc[0][r]); mx = fmaxf(mx, sc[1][r]); }
    {
      auto sw = __builtin_amdgcn_permlane32_swap(__float_as_uint(mx), __float_as_uint(mx), false, false);
      mx = fmaxf(__uint_as_float(sw[0]), __uint_as_float(sw[1]));
    }
    if (kt == 0 || __builtin_amdgcn_ballot_w64(mx > 8.f) != 0) {
      const float delta = (kt == 0) ? mx : fmaxf(mx, 0.f);
      const float alpha = (kt == 0) ? 1.f : __builtin_amdgcn_exp2f(-delta);
      m_run += delta;
      l_run *= alpha;
#pragma unroll
      for (int d = 0; d < DB; ++d)
#pragma unroll
        for (int r = 0; r < 16; ++r) O[d][r] *= alpha;
#pragma unroll
      for (int kb = 0; kb < 2; ++kb)
#pragma unroll
        for (int r = 0; r < 16; ++r) sc[kb][r] -= delta;
    }
    float psum = 0.f;
#pragma unroll
    for (int kb = 0; kb < 2; ++kb)
#pragma unroll
      for (int r = 0; r < 16; ++r) { float e = __builtin_amdgcn_exp2f(sc[kb][r]); sc[kb][r] = e; psum += e; }
    l_run += psum;
    bf16x8 pf[4];
#pragma unroll
    for (int s2 = 0; s2 < 4; ++s2) {
      const int kb = s2 >> 1, r0 = (s2 & 1) * 8;
      u32x4 u = {pack2(sc[kb][r0 + 0], sc[kb][r0 + 1]), pack2(sc[kb][r0 + 2], sc[kb][r0 + 3]),
                 pack2(sc[kb][r0 + 4], sc[kb][r0 + 5]), pack2(sc[kb][r0 + 6], sc[kb][r0 + 7])};
      pf[s2] = __builtin_bit_cast(bf16x8, u);
    }
#pragma unroll
    for (int d = 0; d < DB; ++d) {
#pragma unroll
      for (int s2 = 0; s2 < 4; ++s2) {
        const int kbase = (s2 >> 1) * 32 + (s2 & 1) * 16 + 8 * hf;
        const bf16x8 vf = *(const bf16x8*)(sv + (d * 32 + l32) * 144 + kbase * 2);
        O[d] = MFMA32(vf, pf[s2], O[d]);
      }
    }
    if (kt + 1 < nkt) { ATT_SSTORE((kt + 1) & 1) }
    __syncthreads();
  }
  const float ltot = l_run + __shfl_xor(l_run, 32);
  const float inv = 1.f / ltot;
  u16* cc = (u16*)(ws + OFF_HB) + qrow * 1024;
  if (DIFF) {
    float* X = (float*)smem;
    const int qs = wave & 1;
    if (m == 1) {
#pragma unroll
      for (int d = 0; d < DB; ++d)
#pragma unroll
        for (int r = 0; r < 16; ++r) X[((qs * 64 + d * 16 + r) << 6) + lane] = O[d][r] * inv;
    }
    __syncthreads();
    if (m == 0) {
      const float lam = ((const float*)(ws + OFF_SCAL))[l];
      const float oml = 1.f - ((const float*)(ws + OFF_SCAL))[2 + l];
      float ss = 0.f;
#pragma unroll
      for (int d = 0; d < DB; ++d)
#pragma unroll
        for (int r = 0; r < 16; ++r) {
          float o = O[d][r] * inv - lam * X[((qs * 64 + d * 16 + r) << 6) + lane];
          O[d][r] = o; ss += o * o;
        }
      ss += __shfl_xor(ss, 32);
      const float rinv = rsqrtf(ss * (1.f / 128.f) + 1e-5f) * oml;
      const float* sg = p.in[I_SUBLN] + l * 128;
#pragma unroll
      for (int d = 0; d < DB; ++d)
#pragma unroll
        for (int g = 0; g < 4; ++g) {
          const int e = d * 32 + 8 * g + 4 * hf;
          float4 gg = *(const float4*)(sg + e);
          uint2 v = make_uint2(pack2(O[d][4 * g] * rinv * gg.x, O[d][4 * g + 1] * rinv * gg.y),
                               pack2(O[d][4 * g + 2] * rinv * gg.z, O[d][4 * g + 3] * rinv * gg.w));
          *(uint2*)(cc + h * 128 + e) = v;
        }
    }
    __syncthreads();
  } else {
#pragma unroll
    for (int d = 0; d < DB; ++d)
#pragma unroll
      for (int g = 0; g < 4; ++g) {
        const int e = d * 32 + 8 * g + 4 * hf;
        uint2 v = make_uint2(pack2(O[d][4 * g] * inv, O[d][4 * g + 1] * inv), pack2(O[d][4 * g + 2] * inv, O[d][4 * g + 3] * inv));
        *(uint2*)(cc + 512 + h * 64 + e) = v;
      }
  }
}

DI void phase_mixers(const Params& p, int l, char* smem, unsigned xcc) {
  __shared__ int4 s_item4;
  int& s_item = s_item4.x;
  int* ctrs = (int*)(p.ws + OFF_SCAL + 64) + l * 8;
  const int nqA = (l == 0) ? 68 : 64, nqB = (l == 0) ? 34 : 32;
  const int total = 16 + 2 * nqA + 2 * nqB;
  for (int dx = 0; dx < 8; ++dx) {
    const int q = (xcc + dx) & 7;
    while (true) {
      __syncthreads();
      if (TIDX == 0) s_item = atomicAdd(ctrs + q, 1);
      __syncthreads();
      const int j = s_item;
      if (j >= total) break;
      if (j < 16) scan_item(p, l, (2 * q + (j >> 3)) * 8 + (j & 7), smem);
      else if (j < 16 + 2 * nqA) { const int jj = j - 16; attn_item<true>(p, l, (2 * q + jj / nqA) * nqA + jj % nqA, smem); }
      else { const int jj = j - 16 - 2 * nqA; attn_item<false>(p, l, (2 * q + jj / nqB) * nqB + jj % nqB, smem); }
    }
  }
}

DI void phase_rwkv_post(const Params& p, int l) {
  char* ws = p.ws;
  const int lane = TIDX & 63, wave = TIDX >> 6;
  const u16* RB = (const u16*)(ws + OFF_RKVK);
  const u16* KB2 = RB + (size_t)R * 256;
  const u16* VB2 = KB2 + (size_t)R * 256;
  const int c = lane * 4;
  const float4 ka = *(const float4*)(p.in[I_KA] + l * 256 + c);
  const float4 rk = *(const float4*)(p.in[I_RK] + l * 256 + c);
  const float4 gg = *(const float4*)(p.in[I_GNG] + l * 256 + c);
  const float4 gb = *(const float4*)(p.in[I_GNB] + l * 256 + c);
  for (int row = blockIdx.x * 4 + wave; row < R; row += gridDim.x * 4) {
    if (l == 1 && (row % TT) < CTX) continue;
    const size_t ro = (size_t)row * 256 + c;
    float4 y = *(const float4*)((const float*)(ws + OFF_YS) + ro);
    uint2 ru = *(const uint2*)(RB + ro), ku = *(const uint2*)(KB2 + ro), vu = *(const uint2*)(VB2 + ro);
    uint2 af = *(const uint2*)((const u16*)(ws + OFF_AD) + ro), ab = *(const uint2*)((const u16*)(ws + OFF_AD) + (size_t)R * 256 + ro);
    uint2 gu = *(const uint2*)((const u16*)(ws + OFF_GATE) + ro);
    float s1 = y.x + y.y + y.z + y.w;
    s1 = sum16(s1);
    const float mu = s1 * (1.f / 64.f);
    float d0 = y.x - mu, d1 = y.y - mu, d2 = y.z - mu, d3 = y.w - mu;
    float s2 = sum16(d0 * d0 + d1 * d1 + d2 * d2 + d3 * d3);
    const float rs = rsqrtf(s2 * (1.f / 64.f) + 64e-5f);
    float r0 = lo_bf(ru.x), r1 = hi_bf(ru.x), r2 = lo_bf(ru.y), r3 = hi_bf(ru.y);
    float k0 = lo_bf(ku.x), k1 = hi_bf(ku.x), k2 = lo_bf(ku.y), k3 = hi_bf(ku.y);
    float bsum = 0.f;
    {
      float a0 = lo_bf(af.x), a1 = hi_bf(af.x), a2 = lo_bf(af.y), a3 = hi_bf(af.y);
      bsum += r0 * k0 * (1.f + (a0 - 1.f) * ka.x) * rk.x + r1 * k1 * (1.f + (a1 - 1.f) * ka.y) * rk.y +
              r2 * k2 * (1.f + (a2 - 1.f) * ka.z) * rk.z + r3 * k3 * (1.f + (a3 - 1.f) * ka.w) * rk.w;
      a0 = lo_bf(ab.x); a1 = hi_bf(ab.x); a2 = lo_bf(ab.y); a3 = hi_bf(ab.y);
      bsum += r0 * k0 * (1.f + (a0 - 1.f) * ka.x) * rk.x + r1 * k1 * (1.f + (a1 - 1.f) * ka.y) * rk.y +
              r2 * k2 * (1.f + (a2 - 1.f) * ka.z) * rk.z + r3 * k3 * (1.f + (a3 - 1.f) * ka.w) * rk.w;
    }
    bsum = sum16(bsum);
    float o0 = (d0 * rs * gg.x + gb.x + bsum * lo_bf(vu.x)) * lo_bf(gu.x);
    float o1 = (d1 * rs * gg.y + gb.y + bsum * hi_bf(vu.x)) * hi_bf(gu.x);
    float o2 = (d2 * rs * gg.z + gb.z + bsum * lo_bf(vu.y)) * lo_bf(gu.y);
    float o3 = (d3 * rs * gg.w + gb.w + bsum * hi_bf(vu.y)) * hi_bf(gu.y);
    *(uint2*)((u16*)(ws + OFF_HB) + (size_t)row * 1024 + 768 + c) = make_uint2(pack2(o0, o1), pack2(o2, o3));
  }
}

DI void phase_gemm_raw(const Params& p, int l, const u16* A, int lda, const u16* Wt, int K, float* out, char* smem) {
  XCD_TILE_LOOP(128, 8, 8) {
    XCD_TILE_DECODE(8, 8, ma, nt)
    const int mt = (ma >> 5) * 34 + 2 + (ma & 31);
    const int row0 = mt * 128;
    gemm_tile(A, lda, row0, 0, R, Wt + (size_t)nt * 128 * K, K, K, smem);
    store_bf16((const float*)smem, 0, 128, (u16*)out, 1024, row0, nt * 128);
  }
  if (l == 0) {
    const int Kq = K >> 2;
    for (int it = blockIdx.x; it < 256; it += gridDim.x) {
      const int kq = it & 3, nt = (it >> 2) & 7, cm = it >> 5;
      const int row0 = (cm >> 1) * TT + (cm & 1) * 128;
      gemm_tile(A + kq * Kq, lda, row0, 0, R, Wt + (size_t)nt * 128 * K + kq * Kq, K, Kq, smem);
      store_bf16((const float*)smem, 0, 128, (u16*)(p.ws + OFF_PART) + (size_t)kq * 1024 * 1024, 1024, cm * 128, nt * 128);
    }
  }
}

DI void phase_ffn_up(const Params& p, int l, char* smem) {
  char* ws = p.ws;
  const float* cw = p.in[I_CONVW] + (size_t)l * 3 * 5632;
  const float* cb = p.in[I_CONVB] + (size_t)l * 5632;
  u16* act = (u16*)(ws + OFF_ACT);
  const int mtn = (l == 0) ? 144 : 132;
  XCD_TILE_LOOP(mtn, 44, 11) {
    XCD_TILE_DECODE(44, 11, ma, nt)
    const int b = (l == 0) ? ma / 36 : ma / 33, r = (l == 0) ? ma % 36 : 3 + ma % 33;
    int segbase, seglen, t0;
    if (r < 3) { segbase = b * TT; seglen = CTX; t0 = r * 126; }
    else { segbase = b * TT + CTX; seglen = SEQ; t0 = (r - 3) * 126; }
    gemm_tile((const u16*)(ws + OFF_HB), 1024, segbase + t0 - 1, segbase, segbase + seglen,
              (const u16*)(ws + OFF_WT_UP) + (size_t)nt * 128 * 1024, 1024, 1024, smem);
    const float* T = (const float*)smem;
    const int tid_ = TIDX;
    const int j = 2 * (tid_ & 31), i0 = 1 + (tid_ >> 5) * 16;
    const int cg0 = nt * 64 + j;
    float wg[2][3], wv[2][3], bg[2], bv[2];
#pragma unroll
    for (int q = 0; q < 2; ++q) {
#pragma unroll
      for (int k = 0; k < 3; ++k) { wg[q][k] = cw[k * 5632 + cg0 + q]; wv[q][k] = cw[k * 5632 + DFF + cg0 + q]; }
      bg[q] = cb[cg0 + q]; bv[q] = cb[DFF + cg0 + q];
    }
    float gp[2], gc[2], vp[2], vc[2];
#pragma unroll
    for (int q = 0; q < 2; ++q) {
      gp[q] = T[(i0 - 1) * TS + j + q]; vp[q] = T[(i0 - 1) * TS + 64 + j + q];
      gc[q] = T[i0 * TS + j + q];       vc[q] = T[i0 * TS + 64 + j + q];
    }
#pragma unroll 4
    for (int ii = 0; ii < 16; ++ii) {
      const int i = i0 + ii;
      if (i > 126) break;
      float gn[2], vn[2], res[2];
#pragma unroll
      for (int q = 0; q < 2; ++q) { gn[q] = T[(i + 1) * TS + j + q]; vn[q] = T[(i + 1) * TS + 64 + j + q]; }
#pragma unroll
      for (int q = 0; q < 2; ++q) {
        float g = wg[q][0] * gp[q] + wg[q][1] * gc[q] + wg[q][2] * gn[q] + bg[q];
        float v = wv[q][0] * vp[q] + wv[q][1] * vc[q] + wv[q][2] * vn[q] + bv[q];
        res[q] = g * __builtin_amdgcn_rcpf(1.f + __expf(-g)) * v;
        gp[q] = gc[q]; gc[q] = gn[q]; vp[q] = vc[q]; vc[q] = vn[q];
      }
      const int li = t0 - 1 + i;
      if (li < seglen) *(unsigned*)(act + (size_t)(segbase + li) * DFF + cg0) = pack2(res[0], res[1]);
    }
  }
}

#define XB_TMO      128
#define XB_XCNT(j)  (256  + 64 * (j))
#define XB_XSUB(j)  (1280 + 64 * (j))
#define XB_XGEN(j)  (2304 + 64 * (j))
#define XB_TOP      3328
#define XB_TOPGEN   3392
#define XCD_BAR_WORDS 3456
#define XB_SPIN_CAP (1u << 24)
#define LAS __attribute__((address_space(3)))
DI unsigned xb_ld(unsigned* p) { return __hip_atomic_load(p, __ATOMIC_RELAXED, __HIP_MEMORY_SCOPE_AGENT); }
DI unsigned xb_add(unsigned* p, unsigned v) { return __hip_atomic_fetch_add(p, v, __ATOMIC_RELAXED, __HIP_MEMORY_SCOPE_AGENT); }
DI unsigned xb_xcc_id() { return (unsigned)__builtin_amdgcn_s_getreg((3 << 11) | 20) & 0xFu; }
#define XB_SPIN(cond, bar) do { unsigned _sp = 0; while (cond) { __builtin_amdgcn_s_sleep(1); \
    if ((++_sp & 255u) == 0u) { if (xb_ld(&(bar)[XB_TMO])) break; if (_sp > XB_SPIN_CAP) { atomicAdd(&(bar)[XB_TMO], 1u); break; } } } } while (0)
struct XcdBarrier { unsigned* bar; unsigned x; volatile LAS unsigned* st; };
DI XcdBarrier xcd_barrier_post(unsigned* bar, volatile LAS unsigned* st) {
  XcdBarrier b; b.bar = bar; b.x = xb_xcc_id(); b.st = st;
  if (threadIdx.x == 0) (void)xb_add(&bar[XB_XCNT(b.x)], 1u);
  return b;
}
DI void xcd_barrier_complete(unsigned* bar, unsigned x, unsigned& nloc, unsigned& nx) {
  const unsigned G = gridDim.x * gridDim.y * gridDim.z;
  unsigned sum, cnt, mine, sp = 0u;
  for (;;) {
    sum = 0u; cnt = 0u; mine = 0u;
#pragma unroll
    for (unsigned j = 0; j < 16; ++j) { const unsigned c = xb_ld(&bar[XB_XCNT(j)]); sum += c; cnt += (c > 0u) ? 1u : 0u; mine = (j == x) ? c : mine; }
    if (sum == G) break;
    __builtin_amdgcn_s_sleep(1);
    if ((++sp & 255u) == 0u) { if (xb_ld(&bar[XB_TMO])) break; if (sp > XB_SPIN_CAP) { atomicAdd(&bar[XB_TMO], 1u); break; } }
  }
  nloc = mine > 0u ? mine : 1u; nx = cnt > 0u ? cnt : 1u;
}
DI void xcd_barrier(const XcdBarrier& b) {
  asm volatile("s_waitcnt vmcnt(0)" ::: "memory");
  __syncthreads();
  if (threadIdx.x == 0) {
    unsigned* bar = b.bar;
    __builtin_amdgcn_s_waitcnt(0);
    unsigned nloc = b.st[0], nx = b.st[1];
    if (nloc == 0u) { xcd_barrier_complete(bar, b.x, nloc, nx); b.st[0] = nloc; b.st[1] = nx; }
    const unsigned old = xb_add(&bar[XB_XSUB(b.x)], 1u);
    const unsigned gen = old / nloc;
    if (old + 1u == (gen + 1u) * nloc) {
      __builtin_amdgcn_fence(__ATOMIC_RELEASE, "agent");
      asm volatile("s_waitcnt vmcnt(0)" ::: "memory");
      const unsigned og = xb_add(&bar[XB_TOP], 1u);
      const unsigned tg = og / nx;
      if (og + 1u == (tg + 1u) * nx) xb_add(&bar[XB_TOPGEN], 1u);
      else XB_SPIN(xb_ld(&bar[XB_TOPGEN]) == tg, bar);
      __builtin_amdgcn_fence(__ATOMIC_ACQUIRE, "agent");
      xb_add(&bar[XB_XGEN(b.x)], 1u);
      asm volatile("s_waitcnt vmcnt(0)" ::: "memory");
    } else {
      XB_SPIN(xb_ld(&bar[XB_XGEN(b.x)]) == gen, bar);
      __builtin_amdgcn_fence(__ATOMIC_ACQUIRE, "agent");
      asm volatile("s_waitcnt vmcnt(0)" ::: "memory");
    }
  }
  __syncthreads();
}

__global__ void __launch_bounds__(256, 2) fwd_megakernel(Params p) {
  extern __shared__ __attribute__((aligned(16))) char smem[];
  cg::grid_group grid = cg::this_grid();
  char* ws = p.ws;
  __shared__ uint4 xb_words;
  if (threadIdx.x == 0) xb_words = make_uint4(0u, 0u, 0u, 0u);
  __syncthreads();
  XcdBarrier xb = xcd_barrier_post((unsigned*)(ws + OFF_BAR), (volatile LAS unsigned*)&xb_words);
  if (blockIdx.x == 0) misc_setup(p);
  if (gridDim.x > 448) {
    if (blockIdx.x < 384) mod_item(p, blockIdx.x, smem);
    else for (int it = blockIdx.x - 384; it < NCONV_MIX; it += gridDim.x - 384) convert_mix_item(p, 0, it, smem);
  } else {
    for (int it = blockIdx.x; it < 384 + NCONV_MIX; it += gridDim.x) {
      if (it < 384) mod_item(p, it, smem); else convert_mix_item(p, 0, it - 384, smem);
    }
  }
  if (p.ws == nullptr) grid.sync(); else xcd_barrier(xb);
  for (int l = 0; l < 2; ++l) {
    if (l == 0) norm_phase(p, 0, 0, 2, 0, true, false);
    else {
      norm_phase(p, 2, 0, 2, 1, false, false);
      for (int it = blockIdx.x; it < NCONV_MIX; it += gridDim.x) convert_mix_item(p, 1, it, smem);
    }
    xcd_barrier(xb);
    phase_gemm_in(p, smem);
    xcd_barrier(xb);
    phase_prep(p, l);
    xcd_barrier(xb);
    phase_small_gemms(p, l, smem);
    xcd_barrier(xb);
    phase_mixers(p, l, smem, xb.x);
    xcd_barrier(xb);
    phase_rwkv_post(p, l);
    xcd_barrier(xb);
    phase_gemm_raw(p, l, (const u16*)(ws + OFF_HB), 1024, (const u16*)(ws + OFF_WT_OUT), 1024, (float*)(ws + OFF_RAW), smem);
    xcd_barrier(xb);
    norm_phase(p, 1, l, 1, l, l == 0, l == 1);
    for (int it = blockIdx.x; it < NCONV_FFN; it += gridDim.x) convert_ffn_item(p, l, it, smem);
    xcd_barrier(xb);
    phase_ffn_up(p, l, smem);
    xcd_barrier(xb);
    phase_gemm_raw(p, l, (const u16*)(ws + OFF_ACT), DFF, (const u16*)(ws + OFF_WT_DOWN), DFF, (float*)(ws + OFF_RAW2), smem);
    xcd_barrier(xb);
  }
  norm_phase(p, 2, 1, 0, 0, false, true);
}

extern "C" void kernel_launch(void* const* d_in, const int* in_sizes, int n_in, void* d_out, int out_size,
                              void* d_ws, size_t ws_size, hipStream_t stream) {
  static int grid_blocks = 0;
  if (!grid_blocks) {
    int dev = 0, cus = 0, per_cu = 0;
    hipGetDevice(&dev);
    hipDeviceGetAttribute(&cus, hipDeviceAttributeMultiprocessorCount, dev);
    hipFuncSetAttribute((const void*)fwd_megakernel, hipFuncAttributeMaxDynamicSharedMemorySize, SMEM_BYTES);
    hipOccupancyMaxActiveBlocksPerMultiprocessor(&per_cu, fwd_megakernel, 256, SMEM_BYTES);
    if (per_cu > 2) per_cu = 2;
    if (per_cu < 1) per_cu = 1;
    grid_blocks = cus * per_cu;
  }
  hipMemsetAsync((char*)d_ws + OFF_BAR, 0, XCD_BAR_WORDS * 4, stream);
  Params p{};
  for (int i = 0; i < N_INPUTS; ++i) p.in[i] = (const float*)d_in[i];
  p.out = (float*)d_out;
  p.ws = (char*)d_ws;
  void* args[] = {&p};
  hipError_t e = hipLaunchCooperativeKernel((const void*)fwd_megakernel, dim3(grid_blocks), dim3(256), args, SMEM_BYTES, stream);
  if (e != hipSuccess) fprintf(stderr, "cooperative launch failed: %s (grid %d)\n", hipGetErrorString(e), grid_blocks);
}
```
